# Optimizing an MI355X kernel written in HIP

```python
import math
import jax, jax.numpy as jnp
from jax import lax
import numpy as np

D_MODEL = 1024
BATCH = 8
SEQ = 4096
DEPTH = 2

N_MIXERS = 2
D_FF = 256 * (-(-(8 * D_MODEL) // (3 * 256)))
ROPE_THETA = 10000.0
EPS = 1e-6
NEG_INF = -1e30
A_HEAD_DIM = 64
A_HEADS = D_MODEL // (2 * A_HEAD_DIM)
A_Q_BLOCK = 128
B_HEAD_DIM = 64
B_HEADS = D_MODEL // B_HEAD_DIM
B_GROUPS = ((128, 1), (512, 4), (2048, 16))
B_BLOCK = 64
N_A_LAYERS = (DEPTH + 1) // 2
N_B_LAYERS = DEPTH // 2

kernel_name = 'hybrid_diffattn_dilated_macaron_encoder'


def rms_norm(x, g):
    xf = x.astype(jnp.float32)
    y = xf * lax.rsqrt(jnp.mean(xf * xf, axis=-1, keepdims=True) + EPS)
    return (y * g.astype(jnp.float32)).astype(x.dtype)


def rope_tables(seq, dim):
    inv = ROPE_THETA ** (-jnp.arange(0, dim, 2, dtype=jnp.float32) / dim)
    ang = jnp.arange(seq, dtype=jnp.float32)[:, None] * inv[None, :]
    return jnp.cos(ang), jnp.sin(ang)


def apply_rope(x, cos, sin):
    shape = (cos.shape[0],) + (1,) * (x.ndim - 3) + (cos.shape[1],)
    c, s = cos.reshape(shape), sin.reshape(shape)
    xf = x.astype(jnp.float32)
    x1, x2 = jnp.split(xf, 2, axis=-1)
    return jnp.concatenate([x1 * c - x2 * s, x2 * c + x1 * s], axis=-1).astype(x.dtype)


def swiglu(h, w_gate, w_up, w_down):
    return (jax.nn.silu(h @ w_gate) * (h @ w_up)) @ w_down


def diff_attention(h, w_qkv, w_o, lam, subln, lambda_init, cos, sin):
    B_, S_, _ = h.shape
    q, k, v = jnp.split(h @ w_qkv, 3, axis=-1)
    q = q.reshape(B_, S_, A_HEADS, 2, A_HEAD_DIM)
    k = k.reshape(B_, S_, A_HEADS, 2, A_HEAD_DIM)
    v = v.reshape(B_, S_, A_HEADS, 2 * A_HEAD_DIM)
    q = apply_rope(q, cos, sin) * (A_HEAD_DIM ** -0.5)
    k = apply_rope(k, cos, sin)
    lamf = lam.astype(jnp.float32)
    lam_full = jnp.exp(jnp.sum(lamf[0] * lamf[1])) - jnp.exp(jnp.sum(lamf[2] * lamf[3])) + lambda_init
    nq = S_ // A_Q_BLOCK
    qb = q.reshape(B_, nq, A_Q_BLOCK, A_HEADS, 2, A_HEAD_DIM).transpose(1, 0, 2, 3, 4, 5)

    def block(qblk):
        s = jnp.einsum('bqhcd,bkhcd->bhcqk', qblk, k, preferred_element_type=jnp.float32)
        p = jax.nn.softmax(s, axis=-1)
        a = p[:, :, 0] - lam_full * p[:, :, 1]
        return jnp.einsum('bhqk,bkhe->bqhe', a.astype(v.dtype), v)

    o = lax.map(block, qb)
    o = o.transpose(1, 0, 2, 3, 4).reshape(B_, S_, A_HEADS, 2 * A_HEAD_DIM)
    o = rms_norm(o, subln) * (1.0 - lambda_init)
    return o.reshape(B_, S_, D_MODEL) @ w_o


def dilated_group_attention(q, k, v, dilation, half):
    B_, S_, H_, hd = q.shape
    L = S_ // dilation
    nb = -(-L // B_BLOCK)
    Lp = nb * B_BLOCK

    def to_strided(t):
        t = t.reshape(B_, L, dilation, H_, t.shape[-1]).transpose(0, 2, 3, 1, 4)
        return jnp.pad(t, ((0, 0), (0, 0), (0, 0), (0, Lp - L), (0, 0)))

    def band(t):
        tp = jnp.pad(t, ((0, 0), (0, 0), (0, 0), (B_BLOCK, B_BLOCK), (0, 0)))
        tb = tp.reshape(B_, dilation, H_, nb + 2, B_BLOCK, t.shape[-1])
        return jnp.concatenate([tb[:, :, :, :-2], tb[:, :, :, 1:-1], tb[:, :, :, 2:]], axis=4)

    qb = to_strided(q).reshape(B_, dilation, H_, nb, B_BLOCK, hd)
    kb = band(to_strided(k))
    vb = band(to_strided(v))
    s = jnp.einsum('bphnqe,bphnke->bphnqk', qb, kb, preferred_element_type=jnp.float32)
    qi = jnp.arange(Lp).reshape(nb, B_BLOCK, 1)
    kj = (jnp.arange(nb)[:, None] * B_BLOCK - B_BLOCK + jnp.arange(3 * B_BLOCK)[None, :]).reshape(nb, 1, 3 * B_BLOCK)
    valid = (jnp.abs(qi - kj) <= half) & (kj >= 0) & (kj < L)
    s = jnp.where(valid, s, NEG_INF)
    m = jnp.max(s, axis=-1, keepdims=True)
    p = jnp.exp(s - m)
    den = jnp.sum(p, axis=-1, keepdims=True)
    o = jnp.einsum('bphnqk,bphnke->bphnqe', (p / den).astype(v.dtype), vb)
    lse = m + jnp.log(den)

    def from_strided(t):
        t = t[:, :, :, :L]
        return t.transpose(0, 3, 1, 2, 4).reshape(B_, S_, H_, t.shape[-1])

    o = from_strided(o.reshape(B_, dilation, H_, Lp, hd))
    lse = from_strided(lse.reshape(B_, dilation, H_, Lp, 1))[..., 0]
    return o, lse


def dilated_mixture_attention(h, w_in, w_o, cos, sin):
    B_, S_, _ = h.shape
    n_groups = len(B_GROUPS)
    parts = jnp.split(h @ w_in, 2 * n_groups + 1, axis=-1)
    v = parts[-1].reshape(B_, S_, B_HEADS, B_HEAD_DIM)
    outs, lses = [], []
    for g, (window, dilation) in enumerate(B_GROUPS):
        q = apply_rope(parts[2 * g].reshape(B_, S_, B_HEADS, B_HEAD_DIM), cos, sin) * (B_HEAD_DIM ** -0.5)
        k = apply_rope(parts[2 * g + 1].reshape(B_, S_, B_HEADS, B_HEAD_DIM), cos, sin)
        o, lse = dilated_group_attention(q, k, v, dilation, window // (2 * dilation))
        outs.append(o)
        lses.append(lse)
    alpha = jax.nn.softmax(jnp.stack(lses, axis=0), axis=0)
    o = jnp.sum(jnp.stack(outs, axis=0).astype(jnp.float32) * alpha[..., None], axis=0).astype(h.dtype)
    return o.reshape(B_, S_, D_MODEL) @ w_o


def setup_inputs(seed: int = 0) -> dict:
    key = jax.random.key(seed)
    ks = jax.random.split(key, 20)
    n_in = 2 * len(B_GROUPS) + 1
    f32 = jnp.float32

    def w(k, shape, fan_in):
        return jax.random.normal(k, shape, f32) * (fan_in ** -0.5)

    def gain(k, shape):
        return 1.0 + 0.01 * jax.random.normal(k, shape, f32)

    return {
        'x': jax.random.normal(ks[0], (BATCH, SEQ, D_MODEL), f32),
        'ln_ffn1': gain(ks[1], (DEPTH, D_MODEL)),
        'w1_gate': w(ks[2], (DEPTH, D_MODEL, D_FF), D_MODEL),
        'w1_up': w(ks[3], (DEPTH, D_MODEL, D_FF), D_MODEL),
        'w1_down': w(ks[4], (DEPTH, D_FF, D_MODEL), D_FF),
        'ln_mix': gain(ks[5], (DEPTH, D_MODEL)),
        'a_w_qkv': w(ks[6], (N_A_LAYERS, D_MODEL, 3 * D_MODEL), D_MODEL),
        'a_w_o': w(ks[7], (N_A_LAYERS, D_MODEL, D_MODEL), D_MODEL),
        'a_lambda': 0.1 * jax.random.normal(ks[8], (N_A_LAYERS, 4, A_HEAD_DIM), f32),
        'a_subln': gain(ks[9], (N_A_LAYERS, 2 * A_HEAD_DIM)),
        'b_w_in': w(ks[10], (N_B_LAYERS, D_MODEL, n_in * D_MODEL), D_MODEL),
        'b_w_o': w(ks[11], (N_B_LAYERS, D_MODEL, D_MODEL), D_MODEL),
        'ln_ffn2': gain(ks[12], (DEPTH, D_MODEL)),
        'w2_gate': w(ks[13], (DEPTH, D_MODEL, D_FF), D_MODEL),
        'w2_up': w(ks[14], (DEPTH, D_MODEL, D_FF), D_MODEL),
        'w2_down': w(ks[15], (DEPTH, D_FF, D_MODEL), D_FF),
        'ln_final': gain(ks[16], (D_MODEL,)),
    }


def reference(x, ln_ffn1, w1_gate, w1_up, w1_down, ln_mix, a_w_qkv, a_w_o, a_lambda, a_subln,
              b_w_in, b_w_o, ln_ffn2, w2_gate, w2_up, w2_down, ln_final):
    cos, sin = rope_tables(x.shape[1], A_HEAD_DIM)
    for i in range(DEPTH):
        x = x + 0.5 * swiglu(rms_norm(x, ln_ffn1[i]), w1_gate[i], w1_up[i], w1_down[i])
        h = rms_norm(x, ln_mix[i])
        j = i // N_MIXERS
        if i % N_MIXERS == 0:
            lambda_init = 0.8 - 0.6 * math.exp(-0.3 * i)
            x = x + diff_attention(h, a_w_qkv[j], a_w_o[j], a_lambda[j], a_subln[j], lambda_init, cos, sin)
        else:
            x = x + dilated_mixture_attention(h, b_w_in[j], b_w_o[j], cos, sin)
        x = x + 0.5 * swiglu(rms_norm(x, ln_ffn2[i]), w2_gate[i], w2_up[i], w2_down[i])
    return rms_norm(x, ln_final)
```

```cpp
#include <hip/hip_runtime.h>
#include <hip/hip_cooperative_groups.h>
#include <cstdio>
#include <cstdint>
#include <cmath>
namespace cg = cooperative_groups;
namespace pg8 {
#define PG8_LAS __attribute__((address_space(3)))
typedef unsigned short bf16_t;
typedef short bf16x8 __attribute__((ext_vector_type(8)));
typedef float f32x4 __attribute__((ext_vector_type(4)));
typedef unsigned u32x4 __attribute__((ext_vector_type(4)));
constexpr int BM = 256, BK = 64, HALF = 128, HTB = HALF * BK * 2  , STAGE_BYTES = 8 * HTB, NXCD = 8, WGM = 8;

__host__ __device__ __forceinline__ int lds_byte(int r, int c) { const int st = (r >> 4) * 2 + (c >> 5), rr = r & 15, cc = c & 31, ob = rr * 64 + cc * 2; return st * 1024 + (ob ^ (((ob >> 9) & 1) << 5)); }
__host__ __device__ __forceinline__ void stage_rc(int b, int& R, int& C) { const int st = b / 1024, sb = b % 1024, swz = sb ^ (((sb >> 9) & 1) << 5); R = (st >> 1) * 16 + swz / 64; C = (st & 1) * 32 + (swz % 64) / 2; }
__host__ __device__ __forceinline__ int perm32(int rho) { const int n = rho >> 4, i = rho & 15; return 8 * (i >> 2) + 4 * n + (i & 3); }

struct Unit { int pm, pn; };
struct Gemm { const bf16_t* A; const bf16_t* Bt; int M, N, K; };

struct StaticOrder {
    int nM, nN, nwg, G, c;
    __host__ __device__ void init(int M, int N, int G_, int c_) { nM = M / BM; nN = N / BM; nwg = nM * nN; G = G_; c = c_; }
    __host__ __device__ bool next(int i, Unit& u) const {
        const long L = (long)i * G + c; if (L >= nwg) return false;
        int wgid = (int)L; { const int q = nwg / NXCD, r = nwg % NXCD, xcd = wgid % NXCD, off = wgid / NXCD; wgid = (xcd < r ? xcd * (q + 1) : r * (q + 1) + (xcd - r) * q) + off; }
        const int nig = WGM * nN, gid = wgid / nig, fm = gid * WGM, gsz = (nM - fm) < WGM ? (nM - fm) : WGM;
        u.pm = fm + ((wgid % nig) % gsz); u.pn = (wgid % nig) / gsz; return true;
    }
    __device__ __forceinline__ void a_ready(const Unit&) const {}
    __device__ __forceinline__ void done(const Unit&) const {}
};

__device__ __forceinline__ unsigned cvt_pk_bf16(float lo, float hi) { unsigned r; asm volatile("v_cvt_pk_bf16_f32 %0, %1, %2" : "=v"(r) : "v"(lo), "v"(hi)); return r; }
typedef float f32x2 __attribute__((ext_vector_type(2)));
template <class Epi, class Sched, bool ALIGN_EPI = false, bool SP2 = false>
__device__ __forceinline__ void gemm_phase(PG8_LAS unsigned char* lds, const Gemm g, const Sched& S, const Epi& E) {
    int tid_o = threadIdx.x; asm volatile("" : "+v"(tid_o)); const int tid = tid_o, wid = __builtin_amdgcn_readfirstlane(tid >> 6), lane = tid & 63, wr = wid >> 2, wc = wid & 3, fr = lane & 15, fq = lane >> 4;
    const int K = g.K, nt = K / BK;
    unsigned voffA[2], voffB[2];
#pragma unroll
    for (int i = 0; i < 2; ++i) { int R, C; stage_rc(tid * 16 + i * 8192, R, C); const int Rb = Epi::PERM ? ((R & ~31) + perm32(R & 31)) : R;
        voffA[i] = (unsigned)(R * K + C) * 2u; voffB[i] = (unsigned)(Rb * K + C) * 2u; }
    const size_t kstep = (size_t)(BK * 2);
    const size_t hstep = (size_t)HALF * K * 2;
    const size_t tstep = 2 * hstep;
    const unsigned ldsw = (unsigned)wid * 1024u;
    const int aoff = lds_byte(wr * 64 + fr, fq * 8), boff = lds_byte(wc * 32 + fr, fq * 8);
#define PG8_SA(b, h) (((b) * 2 + (h)) * HTB)
#define PG8_SB(b, h) ((4 + (b) * 2 + (h)) * HTB)
#define PG8_STAGE(bufoff, gbase, voff) do { _Pragma("unroll") for (int _i = 0; _i < 2; ++_i) \
        __builtin_amdgcn_global_load_lds((const unsigned*)((const char*)(gbase) + (voff)[_i]), (PG8_LAS unsigned*)(lds + (bufoff) + ldsw + _i * 8192), 16, 0, 0); } while (0)
#define PG8_LDA(dst, b, h) do { _Pragma("unroll") for (int m = 0; m < 4; ++m) _Pragma("unroll") for (int k = 0; k < 2; ++k) dst[m][k] = *(const PG8_LAS bf16x8*)(lds + PG8_SA(b, h) + aoff + m * 2048 + k * 1024); } while (0)
#define PG8_LDB(dst, b, h) do { _Pragma("unroll") for (int n = 0; n < 2; ++n) _Pragma("unroll") for (int k = 0; k < 2; ++k) dst[n][k] = *(const PG8_LAS bf16x8*)(lds + PG8_SB(b, h) + boff + n * 2048 + k * 1024); } while (0)
#define PG8_MMA(ai, bj, At, Bt) do { __builtin_amdgcn_s_setprio(1); _Pragma("unroll") for (int m = 0; m < 4; ++m) _Pragma("unroll") for (int n = 0; n < 2; ++n) _Pragma("unroll") for (int k = 0; k < 2; ++k) \
        acc[ai][bj][m][n] = __builtin_amdgcn_mfma_f32_16x16x32_bf16(Bt[n][k], At[m][k], acc[ai][bj][m][n], 0, 0, 0); __builtin_amdgcn_s_setprio(0); } while (0)
#define PG8_WAIT_V(n) asm volatile("s_waitcnt vmcnt(" #n ")" ::: "memory")
#define PG8_WAIT_L(n) asm volatile("s_waitcnt lgkmcnt(" #n ")" ::: "memory")
#define PG8_BAR __builtin_amdgcn_s_barrier()
#define PG8_SCHED __builtin_amdgcn_sched_barrier(0)
    Unit cur, nxt; int ui = 0;
    if (!S.next(0, cur)) return;
    f32x4 acc[2][2][4][2];
#pragma unroll
    for (int a = 0; a < 2; ++a)
#pragma unroll
        for (int b = 0; b < 2; ++b)
#pragma unroll
            for (int m = 0; m < 4; ++m)
#pragma unroll
                for (int n = 0; n < 2; ++n) acc[a][b][m][n] = (f32x4){0.f, 0.f, 0.f, 0.f};
    bf16x8 At[4][2], B0[2][2], B1[2][2];
    const char* cA = (const char*)g.A + (size_t)cur.pm * tstep; const char* cB = (const char*)g.Bt + (size_t)cur.pn * tstep;
    S.a_ready(cur);
    if constexpr (SP2) {
        PG8_STAGE(PG8_SB(0, 0), cB, voffB); PG8_STAGE(PG8_SB(0, 1), cB + hstep, voffB); PG8_STAGE(PG8_SA(0, 0), cA, voffA); PG8_STAGE(PG8_SA(0, 1), cA + hstep, voffA);
        if (wr == 1) PG8_BAR;
        PG8_WAIT_V(2); PG8_BAR;
        PG8_STAGE(PG8_SB(1, 0), cB + kstep, voffB); PG8_STAGE(PG8_SA(1, 0), cA + kstep, voffA); PG8_STAGE(PG8_SB(1, 1), cB + hstep + kstep, voffB);
        PG8_WAIT_V(6); PG8_BAR;
    } else {
        PG8_STAGE(PG8_SB(0, 0), cB, voffB); PG8_STAGE(PG8_SA(0, 0), cA, voffA); PG8_STAGE(PG8_SB(0, 1), cB + hstep, voffB); PG8_STAGE(PG8_SA(0, 1), cA + hstep, voffA);
        if (wr == 1) PG8_BAR;
        PG8_WAIT_V(4); PG8_BAR;
        PG8_STAGE(PG8_SB(1, 0), cB + kstep, voffB); PG8_STAGE(PG8_SA(1, 0), cA + kstep, voffA); PG8_STAGE(PG8_SB(1, 1), cB + hstep + kstep, voffB);
        PG8_WAIT_V(6); PG8_BAR;
    }
    for (;;) {
        const bool has_next = S.next(ui + 1, nxt);
        const char* nA = has_next ? (const char*)g.A + (size_t)nxt.pm * tstep : cA; const char* nB = has_next ? (const char*)g.Bt + (size_t)nxt.pn * tstep : cB;
        for (int t = 0; t < nt; t += 2) {
            const bool last = (t == nt - 2);
            const char* a1 = cA + (size_t)(t + 1) * kstep;
            const char* a2 = last ? nA : cA + (size_t)(t + 2) * kstep; const char* b2 = last ? nB : cB + (size_t)(t + 2) * kstep;
            const char* a3 = a2 + kstep; const char* b3 = b2 + kstep;
            if (last && has_next) S.a_ready(nxt);
            if constexpr (SP2) {
            PG8_LDB(B0, 0, 0); PG8_LDB(B1, 0, 1); PG8_SCHED; PG8_LDA(At, 0, 0); PG8_STAGE(PG8_SA(1, 1), a1 + hstep, voffA);
            PG8_WAIT_V(8); PG8_WAIT_L(0); PG8_BAR; PG8_MMA(0, 0, At, B0); PG8_MMA(0, 1, At, B1); PG8_BAR; PG8_SCHED;
            PG8_LDA(At, 0, 1); PG8_STAGE(PG8_SB(0, 0), b2, voffB); PG8_STAGE(PG8_SB(0, 1), b2 + hstep, voffB); PG8_STAGE(PG8_SA(0, 0), a2, voffA);
            PG8_WAIT_V(8); PG8_WAIT_L(0); PG8_BAR; PG8_MMA(1, 0, At, B0); PG8_MMA(1, 1, At, B1); PG8_BAR; PG8_SCHED;
            PG8_LDB(B0, 1, 0); PG8_LDB(B1, 1, 1); PG8_SCHED; PG8_LDA(At, 1, 0); PG8_STAGE(PG8_SA(0, 1), a2 + hstep, voffA);
            PG8_WAIT_V(8); PG8_WAIT_L(0); PG8_BAR; PG8_MMA(0, 0, At, B0); PG8_MMA(0, 1, At, B1); PG8_BAR; PG8_SCHED;
            PG8_LDA(At, 1, 1); PG8_STAGE(PG8_SB(1, 0), b3, voffB); PG8_STAGE(PG8_SB(1, 1), b3 + hstep, voffB); PG8_STAGE(PG8_SA(1, 0), a3, voffA);
            PG8_WAIT_V(8); PG8_WAIT_L(0); PG8_BAR; PG8_MMA(1, 0, At, B0); PG8_MMA(1, 1, At, B1); PG8_BAR; PG8_SCHED;
            } else {
            PG8_LDB(B0, 0, 0); PG8_SCHED; PG8_LDA(At, 0, 0); PG8_STAGE(PG8_SA(1, 1), a1 + hstep, voffA);
            PG8_WAIT_L(8); PG8_BAR; PG8_WAIT_L(0); PG8_MMA(0, 0, At, B0); PG8_BAR; PG8_SCHED;
            PG8_LDB(B1, 0, 1); PG8_STAGE(PG8_SB(0, 0), b2, voffB);
            PG8_BAR; PG8_WAIT_L(0); PG8_MMA(0, 1, At, B1); PG8_BAR;
            PG8_LDA(At, 0, 1); PG8_STAGE(PG8_SA(0, 0), a2, voffA);
            PG8_BAR; PG8_WAIT_L(0); PG8_MMA(1, 0, At, B0); PG8_BAR; PG8_SCHED;
            PG8_STAGE(PG8_SB(0, 1), b2 + hstep, voffB);
            PG8_WAIT_V(6); PG8_BAR; PG8_MMA(1, 1, At, B1); PG8_BAR;
            PG8_LDB(B0, 1, 0); PG8_SCHED; PG8_LDA(At, 1, 0); PG8_STAGE(PG8_SA(0, 1), a2 + hstep, voffA);
            PG8_WAIT_L(8); PG8_BAR; PG8_WAIT_L(0); PG8_MMA(0, 0, At, B0); PG8_BAR; PG8_SCHED;
            PG8_LDB(B1, 1, 1); PG8_STAGE(PG8_SB(1, 0), b3, voffB);
            PG8_BAR; PG8_WAIT_L(0); PG8_MMA(0, 1, At, B1); PG8_BAR;
            PG8_LDA(At, 1, 1); PG8_STAGE(PG8_SA(1, 0), a3, voffA);
            PG8_BAR; PG8_WAIT_L(0); PG8_MMA(1, 0, At, B0); PG8_BAR; PG8_SCHED;
            PG8_STAGE(PG8_SB(1, 1), b3 + hstep, voffB);
            PG8_WAIT_V(6); PG8_BAR; PG8_MMA(1, 1, At, B1); PG8_BAR;
            }
        }
        if constexpr (ALIGN_EPI) { if (wr == 0) PG8_BAR; }
        if constexpr (!Epi::AFTER_DRAIN) { E(acc, cur, wr, wc, fr, fq); S.done(cur); }
        if (!has_next) break;
#pragma unroll
        for (int a = 0; a < 2; ++a)
#pragma unroll
            for (int b = 0; b < 2; ++b)
#pragma unroll
                for (int m = 0; m < 4; ++m)
#pragma unroll
                    for (int n = 0; n < 2; ++n) acc[a][b][m][n] = (f32x4){0.f, 0.f, 0.f, 0.f};
        cur = nxt; cA = nA; cB = nB; ++ui;
        if constexpr (ALIGN_EPI) { if (wr == 1) PG8_BAR; }
    }
    PG8_WAIT_V(0);
    if constexpr (!ALIGN_EPI) { if (wr == 0) PG8_BAR; }
    PG8_BAR;
    if constexpr (Epi::AFTER_DRAIN) { E.fused(acc, cur, wr, wc, fr, fq, lds, wid, lane); S.done(cur); }
#undef PG8_SA
#undef PG8_SB
#undef PG8_STAGE
#undef PG8_LDA
#undef PG8_LDB
#undef PG8_MMA
#undef PG8_WAIT_V
#undef PG8_WAIT_L
#undef PG8_BAR
#undef PG8_SCHED
}
}

#define LAS __attribute__((address_space(3)))
typedef unsigned short bf16;
typedef short bf16x8 __attribute__((ext_vector_type(8)));
typedef short s16x4 __attribute__((ext_vector_type(4)));
typedef float f32x4 __attribute__((ext_vector_type(4)));
typedef float f32x16 __attribute__((ext_vector_type(16)));
typedef unsigned u32x4 __attribute__((ext_vector_type(4)));
typedef unsigned u32x2 __attribute__((ext_vector_type(2)));

constexpr int BATCH = 8, SEQ = 4096, DM = 1024, MT = BATCH * SEQ, DFF = 2816, NGU = 2 * DFF;
constexpr int NQKV = 3 * DM, NBIN = 7 * DM, MH = MT / 2;
constexpr float EPS = 1e-6f;
constexpr float QSCALE = 0.125f * 1.4426950408889634f;
constexpr float NEGBIG = -1e30f;
constexpr size_t MiB = (size_t)1 << 20;
constexpr size_t WS_SSQ = 0;
constexpr size_t WS_COS = 2 * MiB, WS_SIN = 2 * MiB + 512 * 1024;
constexpr size_t WS_BAR = 3 * MiB;
constexpr size_t WS_W = 4 * MiB;
constexpr size_t FFN_W_BYTES = (size_t)NGU * DM * 2 + (size_t)DM * DFF * 2;
constexpr size_t WS_WQKV = WS_W + 4 * FFN_W_BYTES, WS_WOA = WS_WQKV + 6 * MiB, WS_WIN = WS_WOA + 2 * MiB, WS_WOB = WS_WIN + 14 * MiB;
constexpr size_t WS_XB = 96 * MiB, WS_AO = 160 * MiB, WS_R = 224 * MiB, WS_END = 448 * MiB;
static_assert(WS_WOB + 2 * MiB <= WS_XB, "ws map");
constexpr int LDS_CTL = 136192;
constexpr int LDS_BYTES = LDS_CTL + 256;

struct Params { const float* in[17]; float* out; unsigned char* ws; double invf[32]; };

__device__ __forceinline__ unsigned pk_bf16(float lo, float hi) { return pg8::cvt_pk_bf16(lo, hi); }
__device__ __forceinline__ float fast_exp2(float x) { return __builtin_amdgcn_exp2f(x); }
__device__ __forceinline__ float fast_rcp(float x) { return __builtin_amdgcn_rcpf(x); }
__device__ __forceinline__ float wave_sum(float v) {
#pragma unroll
    for (int o = 1; o < 64; o <<= 1) v += __shfl_xor(v, o);
    return v;
}

__device__ __forceinline__ void load_rstd(const float* ssq, int row0, int fq, float (&rs)[8]) {
#pragma unroll
    for (int hb = 0; hb < 2; ++hb) {
        f32x4 v[4];
#pragma unroll
        for (int i = 0; i < 4; ++i) v[i] = *(const f32x4*)(ssq + (size_t)(row0 + hb * 128 + i * 16) * 16 + 4 * fq);
#pragma unroll
        for (int i = 0; i < 4; ++i) { float s = (v[i].x + v[i].y) + (v[i].z + v[i].w); s += __shfl_xor(s, 16); s += __shfl_xor(s, 32); rs[hb * 4 + i] = rsqrtf(s * (1.0f / DM) + EPS); }
        asm volatile("" ::: "memory");
    }
}
struct EpiSwiGLU {
    static constexpr bool PERM = true, AFTER_DRAIN = false;
    bf16* H; const float* ssq;
    __device__ __forceinline__ void operator()(const f32x4 (&acc)[2][2][4][2], const pg8::Unit& u, int wr, int wc, int fr, int fq) const {
        const int row0 = u.pm * 256 + wr * 64 + fr; float rs[8]; load_rstd(ssq, row0, fq, rs);
        const unsigned b0 = ((unsigned)row0 * DFF + (unsigned)(u.pn * 128 + wc * 32 + 8 * fq)) * 2u;
#pragma unroll
        for (int ai = 0; ai < 2; ++ai)
#pragma unroll
            for (int m = 0; m < 4; ++m) { const float r = rs[ai * 4 + m]; float h[8];
                unsigned bo = b0 + (unsigned)((ai * 128 + m * 16) * DFF * 2); asm volatile("" : "+v"(bo));
#pragma unroll
                for (int n = 0; n < 2; ++n)
#pragma unroll
                    for (int e = 0; e < 4; ++e) { const float g = acc[ai][0][m][n][e] * r, up = acc[ai][1][m][n][e] * r;
                        h[n * 4 + e] = g * fast_rcp(1.0f + fast_exp2(g * -1.4426950408889634f)) * up; }
                u32x4 w; w.x = pk_bf16(h[0], h[1]); w.y = pk_bf16(h[2], h[3]); w.z = pk_bf16(h[4], h[5]); w.w = pk_bf16(h[6], h[7]);
                *(u32x4*)((char*)H + bo) = w; }
    }
};
struct EpiResid {
    static constexpr bool PERM = true, AFTER_DRAIN = false;
    bf16* xb; float* ssq; float scale;
    __device__ __forceinline__ void operator()(const f32x4 (&acc)[2][2][4][2], const pg8::Unit& u, int wr, int wc, int fr, int fq) const {
        const int row0 = u.pm * 256 + wr * 64 + fr;
        const unsigned e0 = (unsigned)row0 * DM + (unsigned)(u.pn * 256 + wc * 32 + 8 * fq);
        const unsigned s0 = ((unsigned)row0 * 16 + (unsigned)(u.pn * 4 + wc)) * 4u;
#pragma unroll
        for (int ai = 0; ai < 2; ++ai) {
            unsigned eo = e0 + (unsigned)(ai * 128 * DM); asm volatile("" : "+v"(eo));
            const unsigned bo2 = eo * 2u;
            u32x4 xi[4][2];
#pragma unroll
            for (int m = 0; m < 4; ++m)
#pragma unroll
                for (int bj = 0; bj < 2; ++bj) xi[m][bj] = *(const u32x4*)((const char*)xb + (bo2 + (unsigned)((m * 16 * DM + bj * 128) * 2)));
#pragma unroll
            for (int m = 0; m < 4; ++m) { float ss = 0.f;
#pragma unroll
                for (int bj = 0; bj < 2; ++bj) { const u32x4 x = xi[m][bj];
                    const f32x4 x0 = (f32x4){__uint_as_float(x.x << 16), __uint_as_float(x.x & 0xffff0000u), __uint_as_float(x.y << 16), __uint_as_float(x.y & 0xffff0000u)};
                    const f32x4 x1 = (f32x4){__uint_as_float(x.z << 16), __uint_as_float(x.z & 0xffff0000u), __uint_as_float(x.w << 16), __uint_as_float(x.w & 0xffff0000u)};
                    const f32x4 y0 = x0 + acc[ai][bj][m][0] * scale, y1 = x1 + acc[ai][bj][m][1] * scale;
                    u32x4 w; w.x = pk_bf16(y0.x, y0.y); w.y = pk_bf16(y0.z, y0.w); w.z = pk_bf16(y1.x, y1.y); w.w = pk_bf16(y1.z, y1.w);
                    *(u32x4*)((char*)xb + (bo2 + (unsigned)((m * 16 * DM + bj * 128) * 2))) = w;
                    ss += (y0.x * y0.x + y0.y * y0.y) + (y0.z * y0.z + y0.w * y0.w) + (y1.x * y1.x + y1.y * y1.y) + (y1.z * y1.z + y1.w * y1.w); }
                ss += __shfl_xor(ss, 16); ss += __shfl_xor(ss, 32);
                if (fq == 0) *(float*)((char*)ssq + (s0 + (unsigned)((ai * 128 + m * 16) * 64))) = ss; }
            asm volatile("" ::: "memory");
        }
    }
};
struct EpiProj {
    static constexpr bool PERM = true, AFTER_DRAIN = false;
    bf16* out; size_t segstride; const float* ssq; const float* cosT; const float* sinT; int rowoff, nrope;
    __device__ __forceinline__ void operator()(const f32x4 (&acc)[2][2][4][2], const pg8::Unit& u, int wr, int wc, int fr, int fq) const {
        const int seg = u.pn >> 2, lrow0 = u.pm * 256 + wr * 64 + fr, grow0 = rowoff + lrow0;
        float rs[8]; load_rstd(ssq, grow0, fq, rs);
        const bool rope = seg < nrope; const float qs = (rope && !(seg & 1)) ? QSCALE : 1.0f;
        char* base = (char*)(out + (size_t)seg * segstride);
        const unsigned b0 = ((unsigned)lrow0 * DM + (unsigned)((u.pn & 3) * 256 + wc * 32 + 8 * fq)) * 2u;
        const unsigned t0 = ((unsigned)(grow0 & (SEQ - 1)) * 32 + (unsigned)(16 * (wc & 1) + 4 * fq)) * 4u;
#pragma unroll
        for (int ai = 0; ai < 2; ++ai)
#pragma unroll
            for (int m = 0; m < 4; ++m) { const float r = rs[ai * 4 + m] * qs;
                unsigned bo = b0 + (unsigned)((ai * 128 + m * 16) * DM * 2), to = t0 + (unsigned)((ai * 128 + m * 16) * 32 * 4); asm volatile("" : "+v"(bo), "+v"(to));
                f32x4 c4 = (f32x4){1.f, 1.f, 1.f, 1.f}, s4 = (f32x4){0.f, 0.f, 0.f, 0.f};
                if (rope) { c4 = *(const f32x4*)((const char*)cosT + to); s4 = *(const f32x4*)((const char*)sinT + to); }
#pragma unroll
                for (int bj = 0; bj < 2; ++bj) { const f32x4 x1 = acc[ai][bj][m][0] * r, x2 = acc[ai][bj][m][1] * r;
                    const f32x4 o1 = x1 * c4 - x2 * s4, o2 = x2 * c4 + x1 * s4;
                    u32x4 w; w.x = pk_bf16(o1.x, o1.y); w.y = pk_bf16(o1.z, o1.w); w.z = pk_bf16(o2.x, o2.y); w.w = pk_bf16(o2.z, o2.w);
                    *(u32x4*)(base + (bo + (unsigned)(bj * 256))) = w; } }
    }
};
#define XB_TMO      128
#define XB_XCNT(j)  (256  + 64 * (j))
#define XB_XSUB(j)  (1280 + 64 * (j))
#define XB_XGEN(j)  (2304 + 64 * (j))
#define XB_TOP      3328
#define XB_TOPGEN   3392
#define XCD_BAR_WORDS 3456
#define XB_SPIN_CAP (1u << 18)

__device__ __forceinline__ unsigned xb_ld(unsigned* p)              { return __hip_atomic_load(p, __ATOMIC_RELAXED, __HIP_MEMORY_SCOPE_AGENT); }
__device__ __forceinline__ unsigned xb_add(unsigned* p, unsigned v) { return __hip_atomic_fetch_add(p, v, __ATOMIC_RELAXED, __HIP_MEMORY_SCOPE_AGENT); }
__device__ __forceinline__ unsigned xb_xcc_id() { return (unsigned)__builtin_amdgcn_s_getreg((3 << 11) | 20) & 0xFu; }
#define XB_SPIN(cond, bar) do { unsigned _sp = 0; while (cond) { __builtin_amdgcn_s_sleep(1); \
    if ((++_sp & 255u) == 0u) { if (xb_ld(&(bar)[XB_TMO])) break; if (_sp > XB_SPIN_CAP) { atomicAdd(&(bar)[XB_TMO], 1u); break; } } } } while (0)

struct XcdBarrier {
    unsigned* bar; unsigned x;
    volatile LAS unsigned* st;
};

__device__ __forceinline__ XcdBarrier xcd_barrier_post(unsigned* bar, volatile LAS unsigned* st) {
    XcdBarrier b; b.bar = bar; b.x = xb_xcc_id(); b.st = st;
    if (threadIdx.x == 0) (void)xb_add(&bar[XB_XCNT(b.x)], 1u);
    return b;
}
__device__ __forceinline__ void xcd_barrier_complete(unsigned* bar, unsigned x, unsigned& nloc, unsigned& nx) {
    const unsigned G = gridDim.x * gridDim.y * gridDim.z;
    unsigned sum, cnt, mine, sp = 0u;
    for (;;) {
        sum = 0u; cnt = 0u; mine = 0u;
#pragma unroll
        for (unsigned j = 0; j < 16; ++j) { const unsigned c = xb_ld(&bar[XB_XCNT(j)]); sum += c; cnt += (c > 0u) ? 1u : 0u; mine = (j == x) ? c : mine; }
        if (sum == G) break;
        __builtin_amdgcn_s_sleep(1);
        if ((++sp & 255u) == 0u) { if (xb_ld(&bar[XB_TMO])) break; if (sp > XB_SPIN_CAP) { atomicAdd(&bar[XB_TMO], 1u); break; } }
    }
    nloc = mine > 0u ? mine : 1u; nx = cnt > 0u ? cnt : 1u;
}

__device__ __forceinline__ void xcd_barrier(const XcdBarrier& b) {
    asm volatile("s_waitcnt vmcnt(0)" ::: "memory");
    __syncthreads();
    int xb_t = threadIdx.x; asm volatile("" : "+v"(xb_t));
    if (xb_t == 0) {
        unsigned* bar = b.bar;
        __builtin_amdgcn_s_waitcnt(0);
        unsigned nloc = b.st[0], nx = b.st[1];
        if (nloc == 0u) { xcd_barrier_complete(bar, b.x, nloc, nx); b.st[0] = nloc; b.st[1] = nx; }
        const unsigned old = xb_add(&bar[XB_XSUB(b.x)], 1u);
        const unsigned gen = old / nloc;
        if (old + 1u == (gen + 1u) * nloc) {
            __builtin_amdgcn_fence(__ATOMIC_RELEASE, "agent");
            asm volatile("s_waitcnt vmcnt(0)" ::: "memory");
            const unsigned og = xb_add(&bar[XB_TOP], 1u);
            const unsigned tg = og / nx;
            if (og + 1u == (tg + 1u) * nx) xb_add(&bar[XB_TOPGEN], 1u);
            else XB_SPIN(xb_ld(&bar[XB_TOPGEN]) == tg, bar);
            __builtin_amdgcn_fence(__ATOMIC_ACQUIRE, "agent");
            xb_add(&bar[XB_XGEN(b.x)], 1u);
            asm volatile("s_waitcnt vmcnt(0)" ::: "memory");
        } else {
            XB_SPIN(xb_ld(&bar[XB_XGEN(b.x)]) == gen, bar);
            __builtin_amdgcn_fence(__ATOMIC_ACQUIRE, "agent");
            asm volatile("s_waitcnt vmcnt(0)" ::: "memory");
        }
    }
    __syncthreads();
}

struct TJob { const float* s0; const float* s1; const float* gain; bf16* dst; int K, N, ldn, mode, nrope; };
__device__ __forceinline__ void tr_item(const TJob& J, LAS float* scr, int item, int lane) {
    const int nblk = J.N / 64, kb = item / nblk, nb = item % nblk, k0 = 32 * kb, n0 = 64 * nb;
    const int nq = lane & 15, np = n0 + 4 * nq; const float* src = J.s0; int col = np;
    if (J.mode == 1) { const int t = np >> 8, bj = (np >> 7) & 1, c = np & 127; src = bj ? J.s1 : J.s0; col = 128 * t + c; }
    else if (J.mode == 2) { const int seg = np >> 10; if (seg < J.nrope) { const int pp = np & 63, w = pp >> 5, fq = (pp >> 3) & 3, n = (pp >> 2) & 1; col = (np & ~63) + 32 * n + 16 * w + 4 * fq; } }
    f32x4 v[8];
#pragma unroll
    for (int i = 0; i < 8; ++i) v[i] = *(const f32x4*)(src + (size_t)(k0 + 4 * i + (lane >> 4)) * J.ldn + col);
#pragma unroll
    for (int i = 0; i < 8; ++i) { const int kk = 4 * i + (lane >> 4); f32x4 x = v[i]; if (J.gain) x = x * J.gain[k0 + kk]; *(LAS f32x4*)(scr + kk * 68 + 4 * nq) = x; }
    asm volatile("s_waitcnt lgkmcnt(0)" ::: "memory");
    u32x4 o[4];
#pragma unroll
    for (int c = 0; c < 4; ++c) { const LAS float* sp = scr + (8 * c) * 68 + lane;
        o[c].x = pk_bf16(sp[0 * 68], sp[1 * 68]); o[c].y = pk_bf16(sp[2 * 68], sp[3 * 68]); o[c].z = pk_bf16(sp[4 * 68], sp[5 * 68]); o[c].w = pk_bf16(sp[6 * 68], sp[7 * 68]); }
    bf16* dp = J.dst + (size_t)(n0 + lane) * J.K + k0;
#pragma unroll
    for (int c = 0; c < 4; ++c) *(u32x4*)(dp + 8 * c) = o[c];
    asm volatile("s_waitcnt lgkmcnt(0)" ::: "memory");
}
constexpr int IT_GU = (DM / 32) * (NGU / 64), IT_D = (DFF / 32) * (DM / 64), IT_FFN = IT_GU + IT_D;
constexpr int IT_QKV = (DM / 32) * (NQKV / 64), IT_O = (DM / 32) * (DM / 64), IT_IN = (DM / 32) * (NBIN / 64);
constexpr int IT_TOTAL = 4 * IT_FFN + IT_QKV + IT_O + IT_IN + IT_O;
__device__ __forceinline__ void prologue(const Params& P, LAS unsigned char* lds, int gw, int NGW, int wave, int lane) {
    unsigned char* ws = P.ws;
    LAS float* scr = (LAS float*)(lds + wave * 16384);
    for (int it = gw; it < IT_TOTAL; it += NGW) {
        int r = it; TJob J; bool found = false;
#pragma unroll
        for (int f = 0; f < 4; ++f) {
            if (!found && r < IT_FFN) { const int l = f >> 1, second = f & 1;
                const float* ln = P.in[second ? 12 : 1] + l * DM; const float* wg = P.in[second ? 13 : 2] + (size_t)l * DM * DFF; const float* wu = P.in[second ? 14 : 3] + (size_t)l * DM * DFF; const float* wd = P.in[second ? 15 : 4] + (size_t)l * DFF * DM;
                bf16* dgu = (bf16*)(ws + WS_W + f * FFN_W_BYTES); bf16* dd = dgu + (size_t)NGU * DM;
                if (r < IT_GU) J = TJob{wg, wu, ln, dgu, DM, NGU, DFF, 1, 0}; else { r -= IT_GU; J = TJob{wd, wd, nullptr, dd, DFF, DM, DM, 0, 0}; }
                found = true; }
            if (!found) r -= IT_FFN;
        }
        if (!found) { if (r < IT_QKV) { J = TJob{P.in[6], P.in[6], P.in[5], (bf16*)(ws + WS_WQKV), DM, NQKV, NQKV, 2, 2}; found = true; } else r -= IT_QKV; }
        if (!found) { if (r < IT_O) { J = TJob{P.in[7], P.in[7], nullptr, (bf16*)(ws + WS_WOA), DM, DM, DM, 0, 0}; found = true; } else r -= IT_O; }
        if (!found) { if (r < IT_IN) { J = TJob{P.in[10], P.in[10], P.in[5] + DM, (bf16*)(ws + WS_WIN), DM, NBIN, NBIN, 2, 6}; found = true; } else r -= IT_IN; }
        if (!found) { J = TJob{P.in[11], P.in[11], nullptr, (bf16*)(ws + WS_WOB), DM, DM, DM, 0, 0}; }
        tr_item(J, scr, r, lane);
    }
    float* cosT = (float*)(ws + WS_COS); float* sinT = (float*)(ws + WS_SIN);
    for (int idx = gw * 64 + lane; idx < SEQ * 32; idx += NGW * 64) {
        const int pos = idx >> 5, i = idx & 31; const float ang = (float)pos * (float)P.invf[i];
        double t = (double)ang * 0.15915494309189535; t -= __builtin_rint(t); const double x = t * 6.283185307179586, x2 = x * x;
        double s = 1.0, c = 1.0;
#pragma unroll
        for (int k = 12; k >= 1; --k) { s = 1.0 - x2 * (1.0 / (double)((2 * k) * (2 * k + 1))) * s; c = 1.0 - x2 * (1.0 / (double)((2 * k - 1) * (2 * k))) * c; }
        cosT[idx] = (float)c; sinT[idx] = (float)(x * s);
    }
    const float* x = P.in[0]; bf16* xb = (bf16*)(ws + WS_XB); float* ssq = (float*)(ws + WS_SSQ);
    for (int row = gw; row < MT; row += NGW) {
        const f32x4* xr = (const f32x4*)(x + (size_t)row * DM) + lane; f32x4 v[4]; float s = 0.f;
#pragma unroll
        for (int j = 0; j < 4; ++j) { v[j] = __builtin_nontemporal_load(xr + 64 * j); s += (v[j].x * v[j].x + v[j].y * v[j].y) + (v[j].z * v[j].z + v[j].w * v[j].w); }
        s = wave_sum(s);
        u32x2* o = (u32x2*)(xb + (size_t)row * DM) + lane;
#pragma unroll
        for (int j = 0; j < 4; ++j) { u32x2 w; w.x = pk_bf16(v[j].x, v[j].y); w.y = pk_bf16(v[j].z, v[j].w); o[64 * j] = w; }
        if (lane < 16) ssq[(size_t)row * 16 + lane] = lane == 0 ? s : 0.f;
    }
}
__device__ __forceinline__ void final_norm(const Params& P, int gw, int NGW, int lane_in) {
    int tid_o = threadIdx.x; asm volatile("" : "+v"(tid_o)); const int lane = tid_o & 63; (void)lane_in;
    const float* ssq = (const float*)(P.ws + WS_SSQ); const float* g = P.in[16]; float* X = P.out; const bf16* xb = (const bf16*)(P.ws + WS_XB);
    f32x4 gv[4];
#pragma unroll
    for (int j = 0; j < 4; ++j) gv[j] = *((const f32x4*)g + lane + 64 * j);
    for (int row = gw; row < MT; row += NGW) {
        float s = lane < 16 ? ssq[(size_t)row * 16 + lane] : 0.f; s = wave_sum(s);
        const float r = rsqrtf(s * (1.0f / DM) + EPS);
        const u32x2* xr = (const u32x2*)(xb + (size_t)row * DM) + lane; f32x4* orow = (f32x4*)(X + (size_t)row * DM) + lane;
#pragma unroll
        for (int j = 0; j < 4; ++j) { const u32x2 w = __builtin_nontemporal_load(xr + 64 * j);
            const f32x4 v = (f32x4){__uint_as_float(w.x << 16), __uint_as_float(w.x & 0xffff0000u), __uint_as_float(w.y << 16), __uint_as_float(w.y & 0xffff0000u)};
            __builtin_nontemporal_store(v * r * gv[j], orow + 64 * j); }
    }
}

__device__ __forceinline__ int crow(int r, int hi) { return (r & 3) + 8 * (r >> 2) + 4 * hi; }
typedef short v4i16_t __attribute__((ext_vector_type(4)));
__device__ __forceinline__ s16x4 tr_read(const LAS unsigned char* p) { return __builtin_bit_cast(s16x4, __builtin_amdgcn_ds_read_tr16_b64_v4i16((LAS v4i16_t*)p)); }
__device__ __forceinline__ bf16x8 cat8(s16x4 lo, s16x4 hi) { return (bf16x8){lo[0], lo[1], lo[2], lo[3], hi[0], hi[1], hi[2], hi[3]}; }
__device__ __forceinline__ float max3f(float a, float b, float c) { float r; asm("v_max3_f32 %0, %1, %2, %3" : "=v"(r) : "v"(a), "v"(b), "v"(c)); return r; }
__device__ __forceinline__ float max2f(float a, float b) { float r; asm("v_max_f32_e32 %0, %1, %2" : "=v"(r) : "v"(a), "v"(b)); return r; }
typedef float f32x2_t __attribute__((ext_vector_type(2))); typedef __bf16 bf16x2_t __attribute__((ext_vector_type(2)));
__device__ __forceinline__ unsigned cvtpk_s(float lo, float hi) { f32x2_t v = {lo, hi}; bf16x2_t b = __builtin_convertvector(v, bf16x2_t); return __builtin_bit_cast(unsigned, b); }
#define MFMA32(a, b, c) __builtin_amdgcn_mfma_f32_32x32x16_bf16((a), (b), (c), 0, 0, 0)

namespace attA {
constexpr int KPIECE = 1040, VPIECE = 1088, KIMG = 16 * KPIECE, STAGE = KIMG + 16 * VPIECE, NT = SEQ / 64;
template <int IMM> __device__ __forceinline__ void glds16(unsigned voff, const void* sbase_, unsigned lds_dst) { unsigned keep;
    const unsigned long long a_ = (unsigned long long)sbase_;
    const unsigned long long sbase = ((unsigned long long)(unsigned)__builtin_amdgcn_readfirstlane((unsigned)(a_ >> 32)) << 32) | (unsigned)__builtin_amdgcn_readfirstlane((unsigned)a_);
    asm volatile("s_mov_b32 %0, m0\n\ts_mov_b32 m0, %3\n\ts_nop 0\n\tglobal_load_lds_dwordx4 %1, %2 offset:%c4\n\ts_mov_b32 m0, %0" : "=&s"(keep) : "v"(voff), "s"(sbase), "s"(lds_dst), "i"(IMM) : "memory"); }
__device__ __forceinline__ void phase(LAS unsigned char* lds, const bf16* Q, const bf16* K, const bf16* V, bf16* AO, const float* lam, const float* subln, int vcu, int G) {
    int tid_o = threadIdx.x; asm volatile("" : "+v"(tid_o)); const int tid = tid_o, lane = tid & 63, wid = __builtin_amdgcn_readfirstlane(tid >> 6), r32 = lane & 31, hi = lane >> 5, comp = wid & 1, rg = wid >> 1;
    constexpr float OUT_SCALE = 0.8f;
    const unsigned ldsb = (unsigned)(uintptr_t)lds;
    const unsigned goffb = (unsigned)(((16 * (lane >> 4)) * DM + (lane & 15) * 8) * 2);
#define ATT_DMA_P(base_, t_, stage_, p_, img_, pstride_) glds16<0>(goffb + (unsigned)((p_) * 2048), (base_) + (size_t)(t_) * (64 * DM), (unsigned)__builtin_amdgcn_readfirstlane(ldsb + (unsigned)((stage_) * STAGE + (img_) + (p_) * (pstride_))))
#define ATT_DMA_KB(kbase_, t_, stage_) do { ATT_DMA_P(kbase_, t_, stage_, 2 * wid, 0, KPIECE); ATT_DMA_P(kbase_, t_, stage_, 2 * wid + 1, 0, KPIECE); } while (0)
#define ATT_DMA_VB(vbase_, t_, stage_) do { ATT_DMA_P(vbase_, t_, stage_, 2 * wid, KIMG, VPIECE); ATT_DMA_P(vbase_, t_, stage_, 2 * wid + 1, KIMG, VPIECE); } while (0)
    if (vcu < BATCH * 8 * (SEQ / 128)) { const int bh0 = vcu >> 5; const size_t rb0 = (size_t)(bh0 >> 3) * SEQ; const bf16* k0_ = K + rb0 * DM + (bh0 & 7) * 128; const bf16* v0_ = V + rb0 * DM + (bh0 & 7) * 128;
        ATT_DMA_KB(k0_, 0, 2); ATT_DMA_VB(v0_, 0, 2); ATT_DMA_KB(k0_, 1, 3); ATT_DMA_VB(v0_, 1, 3); }
    bf16x8 qr[4];
#define ATT_LOADQ(u_) do { const int bh_ = (u_) >> 5, qb_ = (u_) & 31; int r32q = r32; asm volatile("" : "+v"(r32q)); \
        const bf16* qp_ = Q + ((size_t)(bh_ >> 3) * SEQ + qb_ * 128 + rg * 32 + r32q) * DM + (bh_ & 7) * 128 + comp * 64 + hi * 8; \
        _Pragma("unroll") for (int d0 = 0; d0 < 4; ++d0) qr[d0] = *(const bf16x8*)(qp_ + d0 * 16); } while (0)
    if (vcu < BATCH * 8 * (SEQ / 128)) ATT_LOADQ(vcu);
    for (int u = vcu; u < BATCH * 8 * (SEQ / 128); u += G) {
        const int bh = u >> 5, qb = u & 31, b = bh >> 3, h = bh & 7;
        const size_t rowbase = (size_t)b * SEQ;
        const bf16* kbase = K + rowbase * DM + h * 128; const bf16* vbase = V + rowbase * DM + h * 128;
#define ATT_DMA_K(t_, stage_) ATT_DMA_KB(kbase, t_, stage_)
#define ATT_DMA_V(t_, stage_) ATT_DMA_VB(vbase, t_, stage_)
#define ATT_WAIT_BAR() asm volatile("s_waitcnt vmcnt(0) lgkmcnt(0)\n\ts_barrier" ::: "memory")
        const unsigned kb = (unsigned)((r32 & 15) * KPIECE + (r32 >> 4) * 256 + comp * 128 + hi * 16);
        const unsigned vb0 = (unsigned)(KIMG + (4 * hi + ((lane & 15) >> 2)) * VPIECE + ((lane >> 4) & 1) * 32 + (lane & 3) * 8);
#define SBAR() __builtin_amdgcn_sched_barrier(0)
#define VRD(i) do { const LAS unsigned char* vp_ = lds + (svo + vb0) + (((i) >> 2) * 256 + ((i) & 3) * 64); vlo[(i) % 5] = tr_read(vp_); vhi[(i) % 5] = tr_read(vp_ + 8 * VPIECE); } while (0)
#define PVM(i) oT[(i) & 3] = MFMA32(cat8(vlo[(i) % 5], vhi[(i) % 5]), __builtin_bit_cast(bf16x8, pw[(i) >> 2]), oT[(i) & 3])
#define KRD(j) ka[(j) % 3] = *(const LAS bf16x8*)(lds + (sko + kb) + (((j) & 1) * 512 + ((j) >> 1) * 32))
#define QKM(C0, C1, j) do { if ((j) == 0) C0 = MFMA32(ka[0], qr[0], negm); else if ((j) == 1) C1 = MFMA32(ka[1], qr[0], negm); \
        else if ((j) & 1) C1 = MFMA32(ka[(j) % 3], qr[(j) >> 1], C1); else C0 = MFMA32(ka[(j) % 3], qr[(j) >> 1], C0); } while (0)
#define MAXSTEP(P0, P1, k) do { mxa = max3f(mxa, P0[2 * (k)], P0[2 * (k) + 1]); mxb = max3f(mxb, P1[2 * (k)], P1[2 * (k) + 1]); } while (0)
#define EXPSTEP2(P, i, W) do { P[2 * (i)] = fast_exp2(P[2 * (i)]); P[2 * (i) + 1] = fast_exp2(P[2 * (i) + 1]); rsum += P[2 * (i)]; rsum2 += P[2 * (i) + 1]; \
        pw[W][(i) & 3] = cvtpk_s(P[2 * (i)], P[2 * (i) + 1]); \
        asm volatile("" : "+v"(pw[W]), "+v"(P), "+v"(rsum), "+v"(rsum2)); } while (0)
#define STEP(first_, DMAK_, DMAV_, P0, P1, C0, C1) do { \
        float mxa = NEGBIG, mxb = NEGBIG, rsum = 0.f, rsum2 = 0.f; \
        PVM(0); MAXSTEP(P0, P1, 0); MAXSTEP(P0, P1, 1); VRD(5); SBAR(); \
        PVM(1); MAXSTEP(P0, P1, 2); MAXSTEP(P0, P1, 3); VRD(6); SBAR(); \
        PVM(2); MAXSTEP(P0, P1, 4); MAXSTEP(P0, P1, 5); VRD(7); SBAR(); \
        PVM(3); MAXSTEP(P0, P1, 6); MAXSTEP(P0, P1, 7); VRD(8); SBAR(); \
        float mx = max2f(mxa, mxb); \
        PVM(4); DMAK_; VRD(9); SBAR(); \
        PVM(5); DMAV_; VRD(10); SBAR(); \
          \
        alpha = 1.f; \
        if (first_ || __any(mx > ATT_THR)) { const float mxx = max2f(mx, __shfl_xor(mx, 32)); const float dl = first_ ? mxx : __builtin_fmaxf(mxx, 0.f); m += dl; alpha = first_ ? 1.f : fast_exp2(-dl);     \
            _Pragma("unroll") for (int r = 0; r < 16; ++r) { P0[r] -= dl; P1[r] -= dl; } \
            _Pragma("unroll") for (int r = 0; r < 16; ++r) negm[r] = -m; } \
        asm volatile("" : "+v"(alpha), "+v"(m), "+v"(negm)); \
        PVM(6);  EXPSTEP2(P0, 0, 0); VRD(11); SBAR(); \
        PVM(7);  EXPSTEP2(P0, 1, 0); VRD(12); SBAR(); \
        PVM(8);  EXPSTEP2(P0, 2, 0); VRD(13); SBAR(); \
        PVM(9);  EXPSTEP2(P0, 3, 0); VRD(14); SBAR(); \
        PVM(10); EXPSTEP2(P0, 4, 1); VRD(15); SBAR(); \
        PVM(11); EXPSTEP2(P0, 5, 1); SBAR(); \
        PVM(12); EXPSTEP2(P0, 6, 1);  SBAR(); \
        PVM(13); EXPSTEP2(P0, 7, 1);   KRD(0); SBAR(); \
        PVM(14); EXPSTEP2(P1, 0, 2); KRD(1); SBAR(); \
        PVM(15); EXPSTEP2(P1, 1, 2); KRD(2); SBAR(); \
        QKM(C0, C1, 0); EXPSTEP2(P1, 2, 2); KRD(3); SBAR(); \
        QKM(C0, C1, 1); EXPSTEP2(P1, 3, 2); KRD(4); SBAR(); \
        QKM(C0, C1, 2); EXPSTEP2(P1, 4, 3); KRD(5); SBAR(); \
        QKM(C0, C1, 3); EXPSTEP2(P1, 5, 3); KRD(6); SBAR(); \
        QKM(C0, C1, 4); EXPSTEP2(P1, 6, 3); KRD(7); SBAR(); \
        QKM(C0, C1, 5); EXPSTEP2(P1, 7, 3); SBAR(); \
        QKM(C0, C1, 6); l = l * alpha + (rsum + rsum2); asm volatile("" : "+v"(l)); SBAR(); \
        QKM(C0, C1, 7); SBAR(); \
        if (__any(alpha != 1.0f)) { _Pragma("unroll") for (int d0 = 0; d0 < 4; ++d0) _Pragma("unroll") for (int r = 0; r < 16; ++r) oT[d0][r] *= alpha; } \
        } while (0)
        ATT_WAIT_BAR();
        f32x16 pA0 = f32x16{}, pA1 = f32x16{}, pB0, pB1;
#pragma unroll
        for (int d0 = 0; d0 < 4; ++d0) { const bf16x8 a0 = *(const LAS bf16x8*)(lds + (2 * STAGE + kb) + d0 * 32), a1 = *(const LAS bf16x8*)(lds + (2 * STAGE + kb) + 512 + d0 * 32); pA0 = MFMA32(a0, qr[d0], pA0); pA1 = MFMA32(a1, qr[d0], pA1); }
        f32x16 oT[4];
#pragma unroll
        for (int d0 = 0; d0 < 4; ++d0) oT[d0] = f32x16{};
        float m = 0.f, l = 0.f, alpha = 1.f; u32x4 pw[4] = {}; f32x16 negm = f32x16{};
        constexpr float ATT_THR = 4.0f;
        s16x4 vlo[5], vhi[5]; bf16x8 ka[3];
        { const unsigned svo = (unsigned)(2 * STAGE); VRD(0); VRD(1); VRD(2); VRD(3); VRD(4); }
#define ATT_ITER(t_, P0, P1, C0, C1) do { \
        ATT_WAIT_BAR(); \
        { const unsigned svo = (unsigned)(((t_) == 0 ? 2 : (((t_) + 1) & 3)) * STAGE), sko = (unsigned)((((t_) + 3) & 3) * STAGE); \
          STEP(((t_) == 0), if ((t_) + 2 < NT) ATT_DMA_K((t_) + 2, (t_) & 3), if ((t_) + 2 < NT) ATT_DMA_V((t_) + 2, (t_) & 3), P0, P1, C0, C1); }     \
        { const unsigned svo = (unsigned)((((t_) + 2) & 3) * STAGE); VRD(0); VRD(1); VRD(2); VRD(3); VRD(4); }     \
        } while (0)
#pragma unroll 1
        for (int t = 0; t < NT; t += 2) {
            ATT_ITER(t, pA0, pA1, pB0, pB1);
            ATT_ITER(t + 1, pB0, pB1, pA0, pA1);
        }
        { const unsigned svo = (unsigned)(((NT + 1) & 3) * STAGE);
#pragma unroll
          for (int s = 0; s < 4; ++s)
#pragma unroll
              for (int d0 = 0; d0 < 4; ++d0) { const LAS unsigned char* vp = lds + (svo + vb0) + (s * 256 + d0 * 64);
                  oT[d0] = MFMA32(cat8(tr_read(vp), tr_read(vp + 8 * VPIECE)), __builtin_bit_cast(bf16x8, pw[s]), oT[d0]); } }
        __syncthreads();
#undef ATT_DMA
#undef ATT_DMA_K
#undef ATT_DMA_V
#undef ATT_WAIT_BAR
#undef SBAR
#undef VRD
#undef PVM
#undef KRD
#undef QKM
#undef MAXSTEP
#undef EXPSTEP
#undef STEP
#undef ATT_ITER
        l += __shfl_xor(l, 32);
        const float inv = 1.0f / l;
        LAS float* mb = (LAS float*)lds;
        if (comp == 1) {
            float lam_full;
            { const float a = lam[lane] * lam[64 + lane], b = lam[128 + lane] * lam[192 + lane]; lam_full = __expf(wave_sum(a)) - __expf(wave_sum(b)) + 0.2f; }
            const float sc = inv * lam_full;
#pragma unroll
            for (int d0 = 0; d0 < 4; ++d0)
#pragma unroll
                for (int r = 0; r < 16; ++r) mb[((d0 * 16 + r) * 4 + rg) * 64 + lane] = oT[d0][r] * sc;
        }
        __syncthreads();
        if (comp == 1 && u + G < BATCH * 8 * (SEQ / 128)) { const int bhn = (u + G) >> 5; const size_t rbn = (size_t)(bhn >> 3) * SEQ; const bf16* kn_ = K + rbn * DM + (bhn & 7) * 128; const bf16* vn_ = V + rbn * DM + (bhn & 7) * 128;
#pragma unroll
            for (int j = 0; j < 4; ++j) { const int p_ = 4 * rg + j;
                ATT_DMA_P(kn_, 0, 2, p_, 0, KPIECE); ATT_DMA_P(vn_, 0, 2, p_, KIMG, VPIECE); ATT_DMA_P(kn_, 1, 3, p_, 0, KPIECE); ATT_DMA_P(vn_, 1, 3, p_, KIMG, VPIECE); } }
        if (comp == 0) {
            float ss = 0.f;
#pragma unroll
            for (int d0 = 0; d0 < 4; ++d0)
#pragma unroll
                for (int r = 0; r < 16; ++r) { const float o = oT[d0][r] * inv - mb[((d0 * 16 + r) * 4 + rg) * 64 + lane]; oT[d0][r] = o; ss += o * o; }
            ss += __shfl_xor(ss, 32);
            const float rstd = rsqrtf(ss * (1.0f / 128.0f) + EPS) * OUT_SCALE;
            int r32o = r32; asm volatile("" : "+v"(r32o));
            bf16* op = AO + (rowbase + qb * 128 + rg * 32 + r32o) * DM + h * 128;
#pragma unroll
            for (int d0 = 0; d0 < 4; ++d0)
#pragma unroll
                for (int gp = 0; gp < 2; ++gp) { u32x2 w[2];
#pragma unroll
                    for (int k = 0; k < 2; ++k) { const int g4 = 2 * gp + k; const f32x4 gl = *(const f32x4*)(subln + 32 * d0 + 8 * g4 + 4 * hi);
                        w[k].x = pk_bf16(oT[d0][4 * g4 + 0] * rstd * gl.x, oT[d0][4 * g4 + 1] * rstd * gl.y); w[k].y = pk_bf16(oT[d0][4 * g4 + 2] * rstd * gl.z, oT[d0][4 * g4 + 3] * rstd * gl.w); }
                    const auto r0 = __builtin_amdgcn_permlane32_swap(w[0].x, w[1].x, false, false), r1 = __builtin_amdgcn_permlane32_swap(w[0].y, w[1].y, false, false);
                    u32x4 o; o.x = r0[0]; o.y = r1[0]; o.z = r0[1]; o.w = r1[1];
                    *(u32x4*)(op + 32 * d0 + 8 * (2 * gp + hi)) = o; }
        }
        if (u + G < BATCH * 8 * (SEQ / 128)) ATT_LOADQ(u + G);
        __syncthreads();
    }
#undef ATT_LOADQ
}
}


namespace attB {
constexpr int OSTR = 68  , VSTW = 128  , VW_BYTES = 32 * VSTW, ACC_BYTES = 256 * OSTR * 4;
__device__ __forceinline__ void phase(LAS unsigned char* lds, const bf16* R, bf16* AO  , int vcu, int G) {
    int tid_o = threadIdx.x; asm volatile("" : "+v"(tid_o)); const int tid = tid_o, lane = tid & 63, wid = __builtin_amdgcn_readfirstlane(tid >> 6), r32 = lane & 31, hi = lane >> 5;
    LAS float* acc = (LAS float*)lds;
    LAS unsigned char* vst = lds + ACC_BYTES + wid * (2 * VW_BYTES);
    const int vfo = (4 * hi + ((lane & 15) >> 2)) * VSTW + ((lane >> 4) & 1) * 32 + (lane & 3) * 8;
    constexpr size_t SEGS = (size_t)MH * DM;
#define ATTB_PARAMS(item_) \
        const int g = (item_) < 2 ? (item_) : 2, dsh = 2 * g, L = SEQ >> dsh, nq = g == 2 ? 16 : 32; \
        const int p = g == 0 ? 0 : (g == 1 ? (wid & 3) : wid + 8 * ((item_) - 2)); \
        const int mq0 = g == 0 ? t0 + 32 * wid : (g == 1 ? (t0 >> 2) + 32 * (wid >> 2) : (t0 >> 4)); \
        const int mk0 = mq0 - 64; (void)nq; (void)L; (void)p; (void)mk0;
#define ATTB_ORDER(jj_) ((jj_) == 0 ? 2 : ((jj_) < 3 ? (jj_) - 1 : (jj_)))
#define ATTB_LOADS(S_, step_) do { ATTB_PARAMS((step_) / 5) const char* Kh_ = (const char*)(R + (size_t)(2 * g + 1) * SEGS + rowbase * DM + h * 64); \
        int lane_o = lane; asm volatile("" : "+v"(lane_o)); const int r32 = lane_o & 31, hi = lane_o >> 5, lane = lane_o;     \
        const int mkb_ = mk0 + 32 * ATTB_ORDER((step_) % 5); int mk_ = mkb_ + r32; mk_ = mk_ < 0 ? 0 : (mk_ >= L ? L - 1 : mk_); \
        const unsigned ko_ = (unsigned)(((mk_ << dsh) + p) * (DM * 2) + hi * 16);        \
        _Pragma("unroll") for (int d0 = 0; d0 < 4; ++d0) ka[S_][d0] = *(const bf16x8*)(Kh_ + (ko_ + (unsigned)(d0 * 32))); \
        _Pragma("unroll") for (int i = 0; i < 4; ++i) { const int idx = lane + 64 * i, row = idx >> 3, ch = idx & 7; int mv = mkb_ + row; mv = mv < 0 ? 0 : (mv >= L ? L - 1 : mv); \
            vv[S_][i] = *(const u32x4*)((const char*)Vh + (unsigned)(((mv << dsh) + p) * (DM * 2) + ch * 16)); } } while (0)
#define ATTB_LOADQ(QS_, item_) do { ATTB_PARAMS(item_) const int tokq_ = ((mq0 + (r32 & (nq - 1))) << dsh) + p; const char* Qh_ = (const char*)(R + (size_t)(2 * g) * SEGS + rowbase * DM + h * 64); \
        const unsigned qo_ = (unsigned)(tokq_ * (DM * 2) + hi * 16); \
        _Pragma("unroll") for (int d0 = 0; d0 < 4; ++d0) qr[QS_][d0] = *(const bf16x8*)(Qh_ + (qo_ + (unsigned)(d0 * 32))); } while (0)
    bf16x8 ka[2][4], qr[2][4]; u32x4 vv[2][4];
    if (vcu < 4 * 16 * 16) { const int blk = vcu & 15, h = (vcu >> 4) & 15, b = vcu >> 8, t0 = blk * 256; const size_t rowbase = (size_t)b * SEQ; const bf16* Vh = R + 6 * SEGS + rowbase * DM + h * 64;
        ATTB_LOADQ(0, 0); ATTB_LOADS(0, 0); }
    for (int u = vcu; u < 4 * 16 * 16; u += G) {
        const int blk = u & 15, h = (u >> 4) & 15, b = u >> 8, t0 = blk * 256;
        const size_t rowbase = (size_t)b * SEQ;
        const bf16* Vh = R + 6 * SEGS + rowbase * DM + h * 64;
        f32x16 oT[2]; float m = 0.f, l = 0.f;
#pragma unroll
        for (int i = 0; i < 4; ++i) { const int idx = lane + 64 * i, row = idx >> 3, ch = idx & 7; *(LAS u32x4*)(vst + row * VSTW + ch * 16) = vv[0][i]; }
#pragma unroll
        for (int step = 0; step < 20; ++step) {
            const int item = step / 5, jj = step % 5, S = step % 2, QS = item & 1;
            ATTB_PARAMS(item)
            const int qi = r32 & (nq - 1), mq = mq0 + qi, tokq = (mq << dsh) + p;
            if (step + 1 < 20) ATTB_LOADS((step + 1) % 2, step + 1);
            if (jj == 0) { if (item + 1 < 4) ATTB_LOADQ((item + 1) & 1, item + 1); oT[0] = f32x16{}; oT[1] = f32x16{}; m = 0.f; l = 0.f; }
            const int mkb = mk0 + 32 * ATTB_ORDER(jj);
            f32x16 p0 = f32x16{};
#pragma unroll
            for (int d0 = 0; d0 < 4; ++d0) p0 = MFMA32(ka[S][d0], qr[QS][d0], p0);
            if (ATTB_ORDER(jj) == 0 || ATTB_ORDER(jj) == 4 || mkb < 0 || mkb + 32 > L) {
                int mqo = mq; asm volatile("" : "+v"(mqo));
                const int base_ = mkb + 4 * hi, lo = max(mqo - 64, 0) - base_, hi_ = min(mqo + 64, L - 1) - base_;
#pragma unroll
                for (int r = 0; r < 16; ++r) { const int c = (r & 3) + 8 * (r >> 2); p0[r] = (((c - lo) | (hi_ - c)) < 0) ? NEGBIG : p0[r]; }
            }
            float mx = max3f(p0[0], p0[1], p0[2]);
#pragma unroll
            for (int r = 3; r < 15; r += 2) mx = max3f(mx, p0[r], p0[r + 1]);
            mx = max2f(mx, p0[15]);
            float alpha = 1.f;
            if (jj == 0 || __any(mx - m > 4.0f)) {
                const auto rr = __builtin_amdgcn_permlane32_swap(__float_as_uint(mx), __float_as_uint(mx), false, false); const float mxx = max2f(__uint_as_float(rr[0]), __uint_as_float(rr[1]));
                const float mnew = jj == 0 ? mxx : max2f(m, mxx); alpha = jj == 0 ? 1.f : fast_exp2(m - mnew); m = mnew;
                if (jj != 0) {
#pragma unroll
                    for (int d0 = 0; d0 < 2; ++d0)
#pragma unroll
                        for (int r = 0; r < 16; ++r) oT[d0][r] *= alpha;
                }
            }
            float rsum = 0.f;
#pragma unroll
            for (int r = 0; r < 16; ++r) { p0[r] = fast_exp2(p0[r] - m); rsum += p0[r]; }
            l = l * alpha + rsum;
            bf16x8 pb[2];
#pragma unroll
            for (int s = 0; s < 2; ++s) { u32x4 w0; w0.x = pk_bf16(p0[8 * s + 0], p0[8 * s + 1]); w0.y = pk_bf16(p0[8 * s + 2], p0[8 * s + 3]); w0.z = pk_bf16(p0[8 * s + 4], p0[8 * s + 5]); w0.w = pk_bf16(p0[8 * s + 6], p0[8 * s + 7]);
                pb[s] = __builtin_bit_cast(bf16x8, w0); }
            asm volatile("s_waitcnt lgkmcnt(0)" ::: "memory");
#pragma unroll
            for (int s = 0; s < 2; ++s)
#pragma unroll
                for (int d0 = 0; d0 < 2; ++d0) { const LAS unsigned char* vp = vst + S * VW_BYTES + vfo + (16 * s) * VSTW + d0 * 64;
                    const bf16x8 vf = cat8(tr_read(vp), tr_read(vp + 8 * VSTW));
                    oT[d0] = MFMA32(vf, pb[s], oT[d0]); }
            if (step + 1 < 20) {
#pragma unroll
                for (int i = 0; i < 4; ++i) { const int idx = lane + 64 * i, row = idx >> 3, ch = idx & 7; *(LAS u32x4*)(vst + ((step + 1) % 2) * VW_BYTES + row * VSTW + ch * 16) = vv[(step + 1) % 2][i]; }
            }
            if (jj == 4) {
                l += __shfl_xor(l, 32);
                const int tl = tokq - t0;
                LAS float* arow = acc + tl * OSTR;
                if (r32 < nq) {
                    if (g == 0) {
#pragma unroll
                        for (int d0 = 0; d0 < 2; ++d0)
#pragma unroll
                            for (int g4 = 0; g4 < 4; ++g4) *(LAS f32x4*)(arow + 32 * d0 + 8 * g4 + 4 * hi) = (f32x4){oT[d0][4 * g4], oT[d0][4 * g4 + 1], oT[d0][4 * g4 + 2], oT[d0][4 * g4 + 3]};
                        if (hi == 0) { arow[64] = m; arow[65] = l; }
                    } else {
                        const float ma = arow[64], la = arow[65];
                        const float mn = fmaxf(ma, m), fa = fast_exp2(ma - mn), fw = fast_exp2(m - mn);
#pragma unroll
                        for (int d0 = 0; d0 < 2; ++d0)
#pragma unroll
                            for (int g4 = 0; g4 < 4; ++g4) { LAS f32x4* ap = (LAS f32x4*)(arow + 32 * d0 + 8 * g4 + 4 * hi); const f32x4 a = *ap;
                                *ap = a * fa + (f32x4){oT[d0][4 * g4], oT[d0][4 * g4 + 1], oT[d0][4 * g4 + 2], oT[d0][4 * g4 + 3]} * fw; }
                        asm volatile("s_waitcnt lgkmcnt(0)" ::: "memory");
                        if (hi == 0) { arow[64] = mn; arow[65] = la * fa + l * fw; }
                    }
                }
                if (item != 2) __syncthreads();
            }
        }
        if (u + G < 4 * 16 * 16) { const int u2 = u + G; const int blk = u2 & 15, h = (u2 >> 4) & 15, b = u2 >> 8, t0 = blk * 256; const size_t rowbase = (size_t)b * SEQ; const bf16* Vh = R + 6 * SEGS + rowbase * DM + h * 64;
            ATTB_LOADQ(0, 0); ATTB_LOADS(0, 0); }
        { const int tl = tid >> 1, hf = tid & 1; const LAS float* arow = acc + tl * OSTR; const float inv = 1.0f / arow[65];
          bf16* op = AO + (rowbase + t0 + tl) * DM + h * 64 + 32 * hf;
#pragma unroll
          for (int c = 0; c < 4; ++c) { const f32x4 a = *(const LAS f32x4*)(arow + 32 * hf + 8 * c) * inv, bq = *(const LAS f32x4*)(arow + 32 * hf + 8 * c + 4) * inv;
              u32x4 w; w.x = pk_bf16(a.x, a.y); w.y = pk_bf16(a.z, a.w); w.z = pk_bf16(bq.x, bq.y); w.w = pk_bf16(bq.z, bq.w); *(u32x4*)(op + 8 * c) = w; } }
        __syncthreads();
    }
#undef ATTB_PARAMS
#undef ATTB_ORDER
#undef ATTB_LOADS
#undef ATTB_LOADQ
}
}


#define GEMM_PHASE(EPI_T, A_, BT_, M_, N_, K_, ...) do { pg8::Gemm g_{(const pg8::bf16_t*)(A_), (const pg8::bf16_t*)(BT_), (M_), (N_), (K_)}; int bx_ = (int)blockIdx.x; asm volatile("" : "+s"(bx_)); pg8::StaticOrder S_; S_.init((M_), (N_), G, bx_);     \
    EPI_T E_{__VA_ARGS__}; pg8::gemm_phase<EPI_T, pg8::StaticOrder, true, true>(lds, g_, S_, E_); } while (0)

__global__ void __launch_bounds__(512, 2) fwd_megakernel(Params P) {
    extern __shared__ __attribute__((aligned(16))) unsigned char lds_raw[];
    LAS unsigned char* lds = (LAS unsigned char*)lds_raw;
    cg::grid_group grid = cg::this_grid();
    const int tid = threadIdx.x, lane = tid & 63, wave = __builtin_amdgcn_readfirstlane(tid >> 6);
    const int G = gridDim.x, bx = blockIdx.x, vcu = (G % 8 == 0) ? (bx % 8) * (G / 8) + bx / 8 : bx;
    const int gw = vcu * 8 + wave, NGW = G * 8;
    unsigned char* ws = P.ws;
    float* ssq = (float*)(ws + WS_SSQ); const float* cosT = (const float*)(ws + WS_COS); const float* sinT = (const float*)(ws + WS_SIN);
    bf16* XB = (bf16*)(ws + WS_XB); bf16* AO = (bf16*)(ws + WS_AO); bf16* R = (bf16*)(ws + WS_R);

    if (tid < 64) ((LAS unsigned*)(lds + LDS_CTL))[tid] = 0u;
    __syncthreads();
    XcdBarrier bar = xcd_barrier_post((unsigned*)(ws + WS_BAR), (volatile LAS unsigned*)(lds + LDS_CTL) + 8);
    prologue(P, lds, gw, NGW, wave, lane);
    grid.sync();
#pragma unroll 1
    for (int layer = 0; layer < 2; ++layer) {
        { const bf16* wgu = (const bf16*)(ws + WS_W + (size_t)(2 * layer) * FFN_W_BYTES); const bf16* wd = wgu + (size_t)NGU * DM;
          GEMM_PHASE(EpiSwiGLU, XB, wgu, MT, NGU, DM, R, ssq);
          xcd_barrier(bar);
          GEMM_PHASE(EpiResid, R, wd, MT, DM, DFF, XB, ssq, 0.5f);
          xcd_barrier(bar); }
        if (layer == 0) {
            GEMM_PHASE(EpiProj, XB, ws + WS_WQKV, MT, NQKV, DM, R, (size_t)MT * DM, ssq, cosT, sinT, 0, 2);
            xcd_barrier(bar);
            attA::phase(lds, R, R + (size_t)MT * DM, R + (size_t)2 * MT * DM, AO, P.in[8], P.in[9], vcu, G);
            xcd_barrier(bar);
            GEMM_PHASE(EpiResid, AO, ws + WS_WOA, MT, DM, DM, XB, ssq, 1.0f);
            xcd_barrier(bar);
        } else {
#pragma unroll 1
            for (int half = 0; half < 2; ++half) {
                GEMM_PHASE(EpiProj, XB + (size_t)half * MH * DM, ws + WS_WIN, MH, NBIN, DM, R, (size_t)MH * DM, ssq, cosT, sinT, half * MH, 6);
                xcd_barrier(bar);
                attB::phase(lds, R, AO + (size_t)half * MH * DM, vcu, G);
                xcd_barrier(bar);
            }
            GEMM_PHASE(EpiResid, AO, ws + WS_WOB, MT, DM, DM, XB, ssq, 1.0f);
            xcd_barrier(bar);
        }
        { const bf16* wgu = (const bf16*)(ws + WS_W + (size_t)(2 * layer + 1) * FFN_W_BYTES); const bf16* wd = wgu + (size_t)NGU * DM;
          GEMM_PHASE(EpiSwiGLU, XB, wgu, MT, NGU, DM, R, ssq);
          xcd_barrier(bar);
          GEMM_PHASE(EpiResid, R, wd, MT, DM, DFF, XB, ssq, 0.5f);
          xcd_barrier(bar); }
    }
    final_norm(P, gw, NGW, lane);
}

extern "C" void kernel_launch(void* const* d_in, const int* in_sizes, int n_in, void* d_out, int out_size, void* d_ws, size_t ws_size, hipStream_t stream) {
    static int grid = 0;
    if (grid == 0) {
        if (n_in != 17 || out_size != MT * DM || ws_size < WS_END) { fprintf(stderr, "kernel_launch: unexpected shapes (n_in %d out %d ws %zu)\n", n_in, out_size, ws_size); grid = -1; return; }
        int dev = 0, cus = 0, per_cu = 0;
        hipGetDevice(&dev); hipDeviceGetAttribute(&cus, hipDeviceAttributeMultiprocessorCount, dev);
        if (hipFuncSetAttribute((const void*)fwd_megakernel, hipFuncAttributeMaxDynamicSharedMemorySize, LDS_BYTES) != hipSuccess) { fprintf(stderr, "kernel_launch: hipFuncSetAttribute failed\n"); grid = -1; return; }
        if (hipOccupancyMaxActiveBlocksPerMultiprocessor(&per_cu, (const void*)fwd_megakernel, 512, LDS_BYTES) != hipSuccess || per_cu < 1) { fprintf(stderr, "kernel_launch: occupancy query failed (%d)\n", per_cu); (void)hipGetLastError(); per_cu = 1; }
        grid = cus * per_cu;
    }
    if (grid < 0) return;
    if (hipMemsetAsync((char*)d_ws + WS_BAR, 0, 16384, stream) != hipSuccess) { fprintf(stderr, "kernel_launch: memset failed\n"); return; }
    Params p{};
    for (int i = 0; i < 17; ++i) p.in[i] = (const float*)d_in[i];
    p.out = (float*)d_out; p.ws = (unsigned char*)d_ws;
    for (int i = 0; i < 32; ++i) p.invf[i] = (double)(float)pow(10000.0, -(double)(2 * i) / 64.0);
    void* args[] = {&p};
    hipError_t e = hipLaunchCooperativeKernel((const void*)fwd_megakernel, dim3(grid), dim3(512), args, LDS_BYTES, stream);
    if (e != hipSuccess) fprintf(stderr, "kernel_launch: cooperative launch failed: %s (grid %d)\n", hipGetErrorString(e), grid);
}
```

```cpp
#include <hip/hip_runtime.h>
#include <hip/hip_cooperative_groups.h>
#include <cstdio>
#include <cstdint>
#include <cmath>
namespace cg = cooperative_groups;
namespace pg8 {
#define PG8_LAS __attribute__((address_space(3)))
typedef unsigned short bf16_t;
typedef short bf16x8 __attribute__((ext_vector_type(8)));
typedef float f32x4 __attribute__((ext_vector_type(4)));
typedef unsigned u32x4 __attribute__((ext_vector_type(4)));
constexpr int BM = 256, BK = 64, HALF = 128, HTB = HALF * BK * 2  , STAGE_BYTES = 8 * HTB, NXCD = 8, WGM = 8;

__host__ __device__ __forceinline__ int lds_byte(int r, int c) { const int st = (r >> 4) * 2 + (c >> 5), rr = r & 15, cc = c & 31, ob = rr * 64 + cc * 2; return st * 1024 + (ob ^ (((ob >> 9) & 1) << 5)); }
__host__ __device__ __forceinline__ void stage_rc(int b, int& R, int& C) { const int st = b / 1024, sb = b % 1024, swz = sb ^ (((sb >> 9) & 1) << 5); R = (st >> 1) * 16 + swz / 64; C = (st & 1) * 32 + (swz % 64) / 2; }
__host__ __device__ __forceinline__ int perm32(int rho) { const int n = rho >> 4, i = rho & 15; return 8 * (i >> 2) + 4 * n + (i & 3); }

struct Unit { int pm, pn; };
struct Gemm { const bf16_t* A; const bf16_t* Bt; int M, N, K; };

struct StaticOrder {
    int nM, nN, nwg, G, c;
    __host__ __device__ void init(int M, int N, int G_, int c_) { nM = M / BM; nN = N / BM; nwg = nM * nN; G = G_; c = c_; }
    __host__ __device__ bool next(int i, Unit& u) const {
        const long L = (long)i * G + c; if (L >= nwg) return false;
        int wgid = (int)L; { const int q = nwg / NXCD, r = nwg % NXCD, xcd = wgid % NXCD, off = wgid / NXCD; wgid = (xcd < r ? xcd * (q + 1) : r * (q + 1) + (xcd - r) * q) + off; }
        const int nig = WGM * nN, gid = wgid / nig, fm = gid * WGM, gsz = (nM - fm) < WGM ? (nM - fm) : WGM;
        u.pm = fm + ((wgid % nig) % gsz); u.pn = (wgid % nig) / gsz; return true;
    }
    __device__ __forceinline__ void a_ready(const Unit&) const {}
    __device__ __forceinline__ void done(const Unit&) const {}
};

__device__ __forceinline__ unsigned cvt_pk_bf16(float lo, float hi) { unsigned r; asm volatile("v_cvt_pk_bf16_f32 %0, %1, %2" : "=v"(r) : "v"(lo), "v"(hi)); return r; }
typedef float f32x2 __attribute__((ext_vector_type(2)));
template <class Epi, class Sched, bool ALIGN_EPI = false, bool SP2 = false>
__device__ __forceinline__ void gemm_phase(PG8_LAS unsigned char* lds, const Gemm g, const Sched& S, const Epi& E) {
    int tid_o = threadIdx.x; asm volatile("" : "+v"(tid_o)); const int tid = tid_o, wid = __builtin_amdgcn_readfirstlane(tid >> 6), lane = tid & 63, wr = wid >> 2, wc = wid & 3, fr = lane & 15, fq = lane >> 4;
    const int K = g.K, nt = K / BK;
    unsigned voffA[2], voffB[2];
#pragma unroll
    for (int i = 0; i < 2; ++i) { int R, C; stage_rc(tid * 16 + i * 8192, R, C); const int Rb = Epi::PERM ? ((R & ~31) + perm32(R & 31)) : R;
        voffA[i] = (unsigned)(R * K + C) * 2u; voffB[i] = (unsigned)(Rb * K + C) * 2u; }
    const size_t kstep = (size_t)(BK * 2);
    const size_t hstep = (size_t)HALF * K * 2;
    const size_t tstep = 2 * hstep;
    const unsigned ldsw = (unsigned)wid * 1024u;
    const int aoff = lds_byte(wr * 64 + fr, fq * 8), boff = lds_byte(wc * 32 + fr, fq * 8);
#define PG8_SA(b, h) (((b) * 2 + (h)) * HTB)
#define PG8_SB(b, h) ((4 + (b) * 2 + (h)) * HTB)
#define PG8_STAGE(bufoff, gbase, voff) do { _Pragma("unroll") for (int _i = 0; _i < 2; ++_i) \
        __builtin_amdgcn_global_load_lds((const unsigned*)((const char*)(gbase) + (voff)[_i]), (PG8_LAS unsigned*)(lds + (bufoff) + ldsw + _i * 8192), 16, 0, 0); } while (0)
#define PG8_LDA(dst, b, h) do { _Pragma("unroll") for (int m = 0; m < 4; ++m) _Pragma("unroll") for (int k = 0; k < 2; ++k) dst[m][k] = *(const PG8_LAS bf16x8*)(lds + PG8_SA(b, h) + aoff + m * 2048 + k * 1024); } while (0)
#define PG8_LDB(dst, b, h) do { _Pragma("unroll") for (int n = 0; n < 2; ++n) _Pragma("unroll") for (int k = 0; k < 2; ++k) dst[n][k] = *(const PG8_LAS bf16x8*)(lds + PG8_SB(b, h) + boff + n * 2048 + k * 1024); } while (0)
#define PG8_MMA(ai, bj, At, Bt) do { __builtin_amdgcn_s_setprio(1); _Pragma("unroll") for (int m = 0; m < 4; ++m) _Pragma("unroll") for (int n = 0; n < 2; ++n) _Pragma("unroll") for (int k = 0; k < 2; ++k) \
        acc[ai][bj][m][n] = __builtin_amdgcn_mfma_f32_16x16x32_bf16(Bt[n][k], At[m][k], acc[ai][bj][m][n], 0, 0, 0); __builtin_amdgcn_s_setprio(0); } while (0)
#define PG8_WAIT_V(n) asm volatile("s_waitcnt vmcnt(" #n ")" ::: "memory")
#define PG8_WAIT_L(n) asm volatile("s_waitcnt lgkmcnt(" #n ")" ::: "memory")
#define PG8_BAR __builtin_amdgcn_s_barrier()
#define PG8_SCHED __builtin_amdgcn_sched_barrier(0)
    Unit cur, nxt; int ui = 0;
    if (!S.next(0, cur)) return;
    f32x4 acc[2][2][4][2];
#pragma unroll
    for (int a = 0; a < 2; ++a)
#pragma unroll
        for (int b = 0; b < 2; ++b)
#pragma unroll
            for (int m = 0; m < 4; ++m)
#pragma unroll
                for (int n = 0; n < 2; ++n) acc[a][b][m][n] = (f32x4){0.f, 0.f, 0.f, 0.f};
    bf16x8 At[4][2], B0[2][2], B1[2][2];
    const char* cA = (const char*)g.A + (size_t)cur.pm * tstep; const char* cB = (const char*)g.Bt + (size_t)cur.pn * tstep;
    S.a_ready(cur);
    if constexpr (SP2) {
        PG8_STAGE(PG8_SB(0, 0), cB, voffB); PG8_STAGE(PG8_SB(0, 1), cB + hstep, voffB); PG8_STAGE(PG8_SA(0, 0), cA, voffA); PG8_STAGE(PG8_SA(0, 1), cA + hstep, voffA);
        if (wr == 1) PG8_BAR;
        PG8_WAIT_V(2); PG8_BAR;
        PG8_STAGE(PG8_SB(1, 0), cB + kstep, voffB); PG8_STAGE(PG8_SA(1, 0), cA + kstep, voffA); PG8_STAGE(PG8_SB(1, 1), cB + hstep + kstep, voffB);
        PG8_WAIT_V(6); PG8_BAR;
    } else {
        PG8_STAGE(PG8_SB(0, 0), cB, voffB); PG8_STAGE(PG8_SA(0, 0), cA, voffA); PG8_STAGE(PG8_SB(0, 1), cB + hstep, voffB); PG8_STAGE(PG8_SA(0, 1), cA + hstep, voffA);
        if (wr == 1) PG8_BAR;
        PG8_WAIT_V(4); PG8_BAR;
        PG8_STAGE(PG8_SB(1, 0), cB + kstep, voffB); PG8_STAGE(PG8_SA(1, 0), cA + kstep, voffA); PG8_STAGE(PG8_SB(1, 1), cB + hstep + kstep, voffB);
        PG8_WAIT_V(6); PG8_BAR;
    }
    for (;;) {
        const bool has_next = S.next(ui + 1, nxt);
        const char* nA = has_next ? (const char*)g.A + (size_t)nxt.pm * tstep : cA; const char* nB = has_next ? (const char*)g.Bt + (size_t)nxt.pn * tstep : cB;
        for (int t = 0; t < nt; t += 2) {
            const bool last = (t == nt - 2);
            const char* a1 = cA + (size_t)(t + 1) * kstep;
            const char* a2 = last ? nA : cA + (size_t)(t + 2) * kstep; const char* b2 = last ? nB : cB + (size_t)(t + 2) * kstep;
            const char* a3 = a2 + kstep; const char* b3 = b2 + kstep;
            if (last && has_next) S.a_ready(nxt);
            if constexpr (SP2) {
            PG8_LDB(B0, 0, 0); PG8_LDB(B1, 0, 1); PG8_SCHED; PG8_LDA(At, 0, 0); PG8_STAGE(PG8_SA(1, 1), a1 + hstep, voffA);
            PG8_WAIT_V(8); PG8_WAIT_L(0); PG8_BAR; PG8_MMA(0, 0, At, B0); PG8_MMA(0, 1, At, B1); PG8_BAR; PG8_SCHED;
            PG8_LDA(At, 0, 1); PG8_STAGE(PG8_SB(0, 0), b2, voffB); PG8_STAGE(PG8_SB(0, 1), b2 + hstep, voffB); PG8_STAGE(PG8_SA(0, 0), a2, voffA);
            PG8_WAIT_V(8); PG8_WAIT_L(0); PG8_BAR; PG8_MMA(1, 0, At, B0); PG8_MMA(1, 1, At, B1); PG8_BAR; PG8_SCHED;
            PG8_LDB(B0, 1, 0); PG8_LDB(B1, 1, 1); PG8_SCHED; PG8_LDA(At, 1, 0); PG8_STAGE(PG8_SA(0, 1), a2 + hstep, voffA);
            PG8_WAIT_V(8); PG8_WAIT_L(0); PG8_BAR; PG8_MMA(0, 0, At, B0); PG8_MMA(0, 1, At, B1); PG8_BAR; PG8_SCHED;
            PG8_LDA(At, 1, 1); PG8_STAGE(PG8_SB(1, 0), b3, voffB); PG8_STAGE(PG8_SB(1, 1), b3 + hstep, voffB); PG8_STAGE(PG8_SA(1, 0), a3, voffA);
            PG8_WAIT_V(8); PG8_WAIT_L(0); PG8_BAR; PG8_MMA(1, 0, At, B0); PG8_MMA(1, 1, At, B1); PG8_BAR; PG8_SCHED;
            } else {
            PG8_LDB(B0, 0, 0); PG8_SCHED; PG8_LDA(At, 0, 0); PG8_STAGE(PG8_SA(1, 1), a1 + hstep, voffA);
            PG8_WAIT_L(8); PG8_BAR; PG8_WAIT_L(0); PG8_MMA(0, 0, At, B0); PG8_BAR; PG8_SCHED;
            PG8_LDB(B1, 0, 1); PG8_STAGE(PG8_SB(0, 0), b2, voffB);
            PG8_BAR; PG8_WAIT_L(0); PG8_MMA(0, 1, At, B1); PG8_BAR;
            PG8_LDA(At, 0, 1); PG8_STAGE(PG8_SA(0, 0), a2, voffA);
            PG8_BAR; PG8_WAIT_L(0); PG8_MMA(1, 0, At, B0); PG8_BAR; PG8_SCHED;
            PG8_STAGE(PG8_SB(0, 1), b2 + hstep, voffB);
            PG8_WAIT_V(6); PG8_BAR; PG8_MMA(1, 1, At, B1); PG8_BAR;
            PG8_LDB(B0, 1, 0); PG8_SCHED; PG8_LDA(At, 1, 0); PG8_STAGE(PG8_SA(0, 1), a2 + hstep, voffA);
            PG8_WAIT_L(8); PG8_BAR; PG8_WAIT_L(0); PG8_MMA(0, 0, At, B0); PG8_BAR; PG8_SCHED;
            PG8_LDB(B1, 1, 1); PG8_STAGE(PG8_SB(1, 0), b3, voffB);
            PG8_BAR; PG8_WAIT_L(0); PG8_MMA(0, 1, At, B1); PG8_BAR;
            PG8_LDA(At, 1, 1); PG8_STAGE(PG8_SA(1, 0), a3, voffA);
            PG8_BAR; PG8_WAIT_L(0); PG8_MMA(1, 0, At, B0); PG8_BAR; PG8_SCHED;
            PG8_STAGE(PG8_SB(1, 1), b3 + hstep, voffB);
            PG8_WAIT_V(6); PG8_BAR; PG8_MMA(1, 1, At, B1); PG8_BAR;
            }
        }
        if constexpr (ALIGN_EPI) { if (wr == 0) PG8_BAR; }
        if constexpr (!Epi::AFTER_DRAIN) { E(acc, cur, wr, wc, fr, fq); S.done(cur); }
        if (!has_next) break;
#pragma unroll
        for (int a = 0; a < 2; ++a)
#pragma unroll
            for (int b = 0; b < 2; ++b)
#pragma unroll
                for (int m = 0; m < 4; ++m)
#pragma unroll
                    for (int n = 0; n < 2; ++n) acc[a][b][m][n] = (f32x4){0.f, 0.f, 0.f, 0.f};
        cur = nxt; cA = nA; cB = nB; ++ui;
        if constexpr (ALIGN_EPI) { if (wr == 1) PG8_BAR; }
    }
    PG8_WAIT_V(0);
    if constexpr (!ALIGN_EPI) { if (wr == 0) PG8_BAR; }
    PG8_BAR;
    if constexpr (Epi::AFTER_DRAIN) { E.fused(acc, cur, wr, wc, fr, fq, lds, wid, lane); S.done(cur); }
#undef PG8_SA
#undef PG8_SB
#undef PG8_STAGE
#undef PG8_LDA
#undef PG8_LDB
#undef PG8_MMA
#undef PG8_WAIT_V
#undef PG8_WAIT_L
#undef PG8_BAR
#undef PG8_SCHED
}
}

#define LAS __attribute__((address_space(3)))
typedef unsigned short bf16;
typedef short bf16x8 __attribute__((ext_vector_type(8)));
typedef short s16x4 __attribute__((ext_vector_type(4)));
typedef float f32x4 __attribute__((ext_vector_type(4)));
typedef float f32x16 __attribute__((ext_vector_type(16)));
typedef unsigned u32x4 __attribute__((ext_vector_type(4)));
typedef unsigned u32x2 __attribute__((ext_vector_type(2)));

constexpr int BATCH = 8, SEQ = 4096, DM = 1024, MT = BATCH * SEQ, DFF = 2816, NGU = 2 * DFF;
constexpr int NQKV = 3 * DM, NBIN = 7 * DM, MH = MT / 2;
constexpr float EPS = 1e-6f;
constexpr float QSCALE = 0.125f * 1.4426950408889634f;
constexpr float NEGBIG = -1e30f;
constexpr size_t MiB = (size_t)1 << 20;
constexpr size_t WS_SSQ = 0;
constexpr size_t WS_COS = 2 * MiB, WS_SIN = 2 * MiB + 512 * 1024;
constexpr size_t WS_BAR = 3 * MiB;
constexpr size_t WS_W = 4 * MiB;
constexpr size_t FFN_W_BYTES = (size_t)NGU * DM * 2 + (size_t)DM * DFF * 2;
constexpr size_t WS_WQKV = WS_W + 4 * FFN_W_BYTES, WS_WOA = WS_WQKV + 6 * MiB, WS_WIN = WS_WOA + 2 * MiB, WS_WOB = WS_WIN + 14 * MiB;
constexpr size_t WS_XB = 96 * MiB, WS_AO = 160 * MiB, WS_R = 224 * MiB, WS_END = 448 * MiB;
static_assert(WS_WOB + 2 * MiB <= WS_XB, "ws map");
constexpr int LDS_CTL = 136192;
constexpr int LDS_BYTES = LDS_CTL + 256;

struct Params { const float* in[17]; float* out; unsigned char* ws; double invf[32]; };

__device__ __forceinline__ unsigned pk_bf16(float lo, float hi) { return pg8::cvt_pk_bf16(lo, hi); }
__device__ __forceinline__ float fast_exp2(float x) { return __builtin_amdgcn_exp2f(x); }
__device__ __forceinline__ float fast_rcp(float x) { return __builtin_amdgcn_rcpf(x); }
__device__ __forceinline__ float wave_sum(float v) {
#pragma unroll
    for (int o = 1; o < 64; o <<= 1) v += __shfl_xor(v, o);
    return v;
}

__device__ __forceinline__ void load_rstd(const float* ssq, int row0, int fq, float (&rs)[8]) {
#pragma unroll
    for (int hb = 0; hb < 2; ++hb) {
        f32x4 v[4];
#pragma unroll
        for (int i = 0; i < 4; ++i) v[i] = *(const f32x4*)(ssq + (size_t)(row0 + hb * 128 + i * 16) * 16 + 4 * fq);
#pragma unroll
        for (int i = 0; i < 4; ++i) { float s = (v[i].x + v[i].y) + (v[i].z + v[i].w); s += __shfl_xor(s, 16); s += __shfl_xor(s, 32); rs[hb * 4 + i] = rsqrtf(s * (1.0f / DM) + EPS); }
        asm volatile("" ::: "memory");
    }
}
struct EpiSwiGLU {
    static constexpr bool PERM = true, AFTER_DRAIN = false;
    bf16* H; const float* ssq;
    __device__ __forceinline__ void operator()(const f32x4 (&acc)[2][2][4][2], const pg8::Unit& u, int wr, int wc, int fr, int fq) const {
        const int row0 = u.pm * 256 + wr * 64 + fr; float rs[8]; load_rstd(ssq, row0, fq, rs);
        const unsigned b0 = ((unsigned)row0 * DFF + (unsigned)(u.pn * 128 + wc * 32 + 8 * fq)) * 2u;
#pragma unroll
        for (int ai = 0; ai < 2; ++ai)
#pragma unroll
            for (int m = 0; m < 4; ++m) { const float r = rs[ai * 4 + m]; float h[8];
                unsigned bo = b0 + (unsigned)((ai * 128 + m * 16) * DFF * 2); asm volatile("" : "+v"(bo));
#pragma unroll
                for (int n = 0; n < 2; ++n)
#pragma unroll
                    for (int e = 0; e < 4; ++e) { const float g = acc[ai][0][m][n][e] * r, up = acc[ai][1][m][n][e] * r;
                        h[n * 4 + e] = g * fast_rcp(1.0f + fast_exp2(g * -1.4426950408889634f)) * up; }
                u32x4 w; w.x = pk_bf16(h[0], h[1]); w.y = pk_bf16(h[2], h[3]); w.z = pk_bf16(h[4], h[5]); w.w = pk_bf16(h[6], h[7]);
                *(u32x4*)((char*)H + bo) = w; }
    }
};
struct EpiResid {
    static constexpr bool PERM = true, AFTER_DRAIN = false;
    bf16* xb; float* ssq; float scale;
    __device__ __forceinline__ void operator()(const f32x4 (&acc)[2][2][4][2], const pg8::Unit& u, int wr, int wc, int fr, int fq) const {
        const int row0 = u.pm * 256 + wr * 64 + fr;
        const unsigned e0 = (unsigned)row0 * DM + (unsigned)(u.pn * 256 + wc * 32 + 8 * fq);
        const unsigned s0 = ((unsigned)row0 * 16 + (unsigned)(u.pn * 4 + wc)) * 4u;
#pragma unroll
        for (int ai = 0; ai < 2; ++ai) {
            unsigned eo = e0 + (unsigned)(ai * 128 * DM); asm volatile("" : "+v"(eo));
            const unsigned bo2 = eo * 2u;
            u32x4 xi[4][2];
#pragma unroll
            for (int m = 0; m < 4; ++m)
#pragma unroll
                for (int bj = 0; bj < 2; ++bj) xi[m][bj] = *(const u32x4*)((const char*)xb + (bo2 + (unsigned)((m * 16 * DM + bj * 128) * 2)));
#pragma unroll
            for (int m = 0; m < 4; ++m) { float ss = 0.f;
#pragma unroll
                for (int bj = 0; bj < 2; ++bj) { const u32x4 x = xi[m][bj];
                    const f32x4 x0 = (f32x4){__uint_as_float(x.x << 16), __uint_as_float(x.x & 0xffff0000u), __uint_as_float(x.y << 16), __uint_as_float(x.y & 0xffff0000u)};
                    const f32x4 x1 = (f32x4){__uint_as_float(x.z << 16), __uint_as_float(x.z & 0xffff0000u), __uint_as_float(x.w << 16), __uint_as_float(x.w & 0xffff0000u)};
                    const f32x4 y0 = x0 + acc[ai][bj][m][0] * scale, y1 = x1 + acc[ai][bj][m][1] * scale;
                    u32x4 w; w.x = pk_bf16(y0.x, y0.y); w.y = pk_bf16(y0.z, y0.w); w.z = pk_bf16(y1.x, y1.y); w.w = pk_bf16(y1.z, y1.w);
                    *(u32x4*)((char*)xb + (bo2 + (unsigned)((m * 16 * DM + bj * 128) * 2))) = w;
                    ss += (y0.x * y0.x + y0.y * y0.y) + (y0.z * y0.z + y0.w * y0.w) + (y1.x * y1.x + y1.y * y1.y) + (y1.z * y1.z + y1.w * y1.w); }
                ss += __shfl_xor(ss, 16); ss += __shfl_xor(ss, 32);
                if (fq == 0) *(float*)((char*)ssq + (s0 + (unsigned)((ai * 128 + m * 16) * 64))) = ss; }
            asm volatile("" ::: "memory");
        }
    }
};
struct EpiProj {
    static constexpr bool PERM = true, AFTER_DRAIN = false;
    bf16* out; size_t segstride; const float* ssq; const float* cosT; const float* sinT; int rowoff, nrope;
    __device__ __forceinline__ void operator()(const f32x4 (&acc)[2][2][4][2], const pg8::Unit& u, int wr, int wc, int fr, int fq) const {
        const int seg = u.pn >> 2, lrow0 = u.pm * 256 + wr * 64 + fr, grow0 = rowoff + lrow0;
        float rs[8]; load_rstd(ssq, grow0, fq, rs);
        const bool rope = seg < nrope; const float qs = (rope && !(seg & 1)) ? QSCALE : 1.0f;
        char* base = (char*)(out + (size_t)seg * segstride);
        const unsigned b0 = ((unsigned)lrow0 * DM + (unsigned)((u.pn & 3) * 256 + wc * 32 + 8 * fq)) * 2u;
        const unsigned t0 = ((unsigned)(grow0 & (SEQ - 1)) * 32 + (unsigned)(16 * (wc & 1) + 4 * fq)) * 4u;
#pragma unroll
        for (int ai = 0; ai < 2; ++ai)
#pragma unroll
            for (int m = 0; m < 4; ++m) { const float r = rs[ai * 4 + m] * qs;
                unsigned bo = b0 + (unsigned)((ai * 128 + m * 16) * DM * 2), to = t0 + (unsigned)((ai * 128 + m * 16) * 32 * 4); asm volatile("" : "+v"(bo), "+v"(to));
                f32x4 c4 = (f32x4){1.f, 1.f, 1.f, 1.f}, s4 = (f32x4){0.f, 0.f, 0.f, 0.f};
                if (rope) { c4 = *(const f32x4*)((const char*)cosT + to); s4 = *(const f32x4*)((const char*)sinT + to); }
#pragma unroll
                for (int bj = 0; bj < 2; ++bj) { const f32x4 x1 = acc[ai][bj][m][0] * r, x2 = acc[ai][bj][m][1] * r;
                    const f32x4 o1 = x1 * c4 - x2 * s4, o2 = x2 * c4 + x1 * s4;
                    u32x4 w; w.x = pk_bf16(o1.x, o1.y); w.y = pk_bf16(o1.z, o1.w); w.z = pk_bf16(o2.x, o2.y); w.w = pk_bf16(o2.z, o2.w);
                    *(u32x4*)(base + (bo + (unsigned)(bj * 256))) = w; } }
    }
};
#define XB_TMO      128
#define XB_XCNT(j)  (256  + 64 * (j))
#define XB_XSUB(j)  (1280 + 64 * (j))
#define XB_XGEN(j)  (2304 + 64 * (j))
#define XB_TOP      3328
#define XB_TOPGEN   3392
#define XCD_BAR_WORDS 3456
#define XB_SPIN_CAP (1u << 18)

__device__ __forceinline__ unsigned xb_ld(unsigned* p)              { return __hip_atomic_load(p, __ATOMIC_RELAXED, __HIP_MEMORY_SCOPE_AGENT); }
__device__ __forceinline__ unsigned xb_add(unsigned* p, unsigned v) { return __hip_atomic_fetch_add(p, v, __ATOMIC_RELAXED, __HIP_MEMORY_SCOPE_AGENT); }
__device__ __forceinline__ unsigned xb_xcc_id() { return (unsigned)__builtin_amdgcn_s_getreg((3 << 11) | 20) & 0xFu; }
#define XB_SPIN(cond, bar) do { unsigned _sp = 0; while (cond) { __builtin_amdgcn_s_sleep(1); \
    if ((++_sp & 255u) == 0u) { if (xb_ld(&(bar)[XB_TMO])) break; if (_sp > XB_SPIN_CAP) { atomicAdd(&(bar)[XB_TMO], 1u); break; } } } } while (0)

struct XcdBarrier {
    unsigned* bar; unsigned x;
    volatile LAS unsigned* st;
};

__device__ __forceinline__ XcdBarrier xcd_barrier_post(unsigned* bar, volatile LAS unsigned* st) {
    XcdBarrier b; b.bar = bar; b.x = xb_xcc_id(); b.st = st;
    if (threadIdx.x == 0) (void)xb_add(&bar[XB_XCNT(b.x)], 1u);
    return b;
}
__device__ __forceinline__ void xcd_barrier_complete(unsigned* bar, unsigned x, unsigned& nloc, unsigned& nx) {
    const unsigned G = gridDim.x * gridDim.y * gridDim.z;
    unsigned sum, cnt, mine, sp = 0u;
    for (;;) {
        sum = 0u; cnt = 0u; mine = 0u;
#pragma unroll
        for (unsigned j = 0; j < 16; ++j) { const unsigned c = xb_ld(&bar[XB_XCNT(j)]); sum += c; cnt += (c > 0u) ? 1u : 0u; mine = (j == x) ? c : mine; }
        if (sum == G) break;
        __builtin_amdgcn_s_sleep(1);
        if ((++sp & 255u) == 0u) { if (xb_ld(&bar[XB_TMO])) break; if (sp > XB_SPIN_CAP) { atomicAdd(&bar[XB_TMO], 1u); break; } }
    }
    nloc = mine > 0u ? mine : 1u; nx = cnt > 0u ? cnt : 1u;
}

__device__ __forceinline__ void xcd_barrier(const XcdBarrier& b) {
    asm volatile("s_waitcnt vmcnt(0)" ::: "memory");
    __syncthreads();
    int xb_t = threadIdx.x; asm volatile("" : "+v"(xb_t));
    if (xb_t == 0) {
        unsigned* bar = b.bar;
        __builtin_amdgcn_s_waitcnt(0);
        unsigned nloc = b.st[0], nx = b.st[1];
        if (nloc == 0u) { xcd_barrier_complete(bar, b.x, nloc, nx); b.st[0] = nloc; b.st[1] = nx; }
        const unsigned old = xb_add(&bar[XB_XSUB(b.x)], 1u);
        const unsigned gen = old / nloc;
        if (old + 1u == (gen + 1u) * nloc) {
            __builtin_amdgcn_fence(__ATOMIC_RELEASE, "agent");
            asm volatile("s_waitcnt vmcnt(0)" ::: "memory");
            const unsigned og = xb_add(&bar[XB_TOP], 1u);
            const unsigned tg = og / nx;
            if (og + 1u == (tg + 1u) * nx) xb_add(&bar[XB_TOPGEN], 1u);
            else XB_SPIN(xb_ld(&bar[XB_TOPGEN]) == tg, bar);
            __builtin_amdgcn_fence(__ATOMIC_ACQUIRE, "agent");
            xb_add(&bar[XB_XGEN(b.x)], 1u);
            asm volatile("s_waitcnt vmcnt(0)" ::: "memory");
        } else {
            XB_SPIN(xb_ld(&bar[XB_XGEN(b.x)]) == gen, bar);
            __builtin_amdgcn_fence(__ATOMIC_ACQUIRE, "agent");
            asm volatile("s_waitcnt vmcnt(0)" ::: "memory");
        }
    }
    __syncthreads();
}

struct TJob { const float* s0; const float* s1; const float* gain; bf16* dst; int K, N, ldn, mode, nrope; };
__device__ __forceinline__ void tr_item(const TJob& J, LAS float* scr, int item, int lane) {
    const int nblk = J.N / 64, kb = item / nblk, nb = item % nblk, k0 = 32 * kb, n0 = 64 * nb;
    const int nq = lane & 15, np = n0 + 4 * nq; const float* src = J.s0; int col = np;
    if (J.mode == 1) { const int t = np >> 8, bj = (np >> 7) & 1, c = np & 127; src = bj ? J.s1 : J.s0; col = 128 * t + c; }
    else if (J.mode == 2) { const int seg = np >> 10; if (seg < J.nrope) { const int pp = np & 63, w = pp >> 5, fq = (pp >> 3) & 3, n = (pp >> 2) & 1; col = (np & ~63) + 32 * n + 16 * w + 4 * fq; } }
    f32x4 v[8];
#pragma unroll
    for (int i = 0; i < 8; ++i) v[i] = *(const f32x4*)(src + (size_t)(k0 + 4 * i + (lane >> 4)) * J.ldn + col);
#pragma unroll
    for (int i = 0; i < 8; ++i) { const int kk = 4 * i + (lane >> 4); f32x4 x = v[i]; if (J.gain) x = x * J.gain[k0 + kk]; *(LAS f32x4*)(scr + kk * 68 + 4 * nq) = x; }
    asm volatile("s_waitcnt lgkmcnt(0)" ::: "memory");
    u32x4 o[4];
#pragma unroll
    for (int c = 0; c < 4; ++c) { const LAS float* sp = scr + (8 * c) * 68 + lane;
        o[c].x = pk_bf16(sp[0 * 68], sp[1 * 68]); o[c].y = pk_bf16(sp[2 * 68], sp[3 * 68]); o[c].z = pk_bf16(sp[4 * 68], sp[5 * 68]); o[c].w = pk_bf16(sp[6 * 68], sp[7 * 68]); }
    bf16* dp = J.dst + (size_t)(n0 + lane) * J.K + k0;
#pragma unroll
    for (int c = 0; c < 4; ++c) *(u32x4*)(dp + 8 * c) = o[c];
    asm volatile("s_waitcnt lgkmcnt(0)" ::: "memory");
}
constexpr int IT_GU = (DM / 32) * (NGU / 64), IT_D = (DFF / 32) * (DM / 64), IT_FFN = IT_GU + IT_D;
constexpr int IT_QKV = (DM / 32) * (NQKV / 64), IT_O = (DM / 32) * (DM / 64), IT_IN = (DM / 32) * (NBIN / 64);
constexpr int IT_TOTAL = 4 * IT_FFN + IT_QKV + IT_O + IT_IN + IT_O;
__device__ __forceinline__ void prologue(const Params& P, LAS unsigned char* lds, int gw, int NGW, int wave, int lane) {
    unsigned char* ws = P.ws;
    LAS float* scr = (LAS float*)(lds + wave * 16384);
    for (int it = gw; it < IT_TOTAL; it += NGW) {
        int r = it; TJob J; bool found = false;
#pragma unroll
        for (int f = 0; f < 4; ++f) {
            if (!found && r < IT_FFN) { const int l = f >> 1, second = f & 1;
                const float* ln = P.in[second ? 12 : 1] + l * DM; const float* wg = P.in[second ? 13 : 2] + (size_t)l * DM * DFF; const float* wu = P.in[second ? 14 : 3] + (size_t)l * DM * DFF; const float* wd = P.in[second ? 15 : 4] + (size_t)l * DFF * DM;
                bf16* dgu = (bf16*)(ws + WS_W + f * FFN_W_BYTES); bf16* dd = dgu + (size_t)NGU * DM;
                if (r < IT_GU) J = TJob{wg, wu, ln, dgu, DM, NGU, DFF, 1, 0}; else { r -= IT_GU; J = TJob{wd, wd, nullptr, dd, DFF, DM, DM, 0, 0}; }
                found = true; }
            if (!found) r -= IT_FFN;
        }
        if (!found) { if (r < IT_QKV) { J = TJob{P.in[6], P.in[6], P.in[5], (bf16*)(ws + WS_WQKV), DM, NQKV, NQKV, 2, 2}; found = true; } else r -= IT_QKV; }
        if (!found) { if (r < IT_O) { J = TJob{P.in[7], P.in[7], nullptr, (bf16*)(ws + WS_WOA), DM, DM, DM, 0, 0}; found = true; } else r -= IT_O; }
        if (!found) { if (r < IT_IN) { J = TJob{P.in[10], P.in[10], P.in[5] + DM, (bf16*)(ws + WS_WIN), DM, NBIN, NBIN, 2, 6}; found = true; } else r -= IT_IN; }
        if (!found) { J = TJob{P.in[11], P.in[11], nullptr, (bf16*)(ws + WS_WOB), DM, DM, DM, 0, 0}; }
        tr_item(J, scr, r, lane);
    }
    float* cosT = (float*)(ws + WS_COS); float* sinT = (float*)(ws + WS_SIN);
    for (int idx = gw * 64 + lane; idx < SEQ * 32; idx += NGW * 64) {
        const int pos = idx >> 5, i = idx & 31; const float ang = (float)pos * (float)P.invf[i];
        double t = (double)ang * 0.15915494309189535; t -= __builtin_rint(t); const double x = t * 6.283185307179586, x2 = x * x;
        double s = 1.0, c = 1.0;
#pragma unroll
        for (int k = 12; k >= 1; --k) { s = 1.0 - x2 * (1.0 / (double)((2 * k) * (2 * k + 1))) * s; c = 1.0 - x2 * (1.0 / (double)((2 * k - 1) * (2 * k))) * c; }
        cosT[idx] = (float)c; sinT[idx] = (float)(x * s);
    }
    const float* x = P.in[0]; bf16* xb = (bf16*)(ws + WS_XB); float* ssq = (float*)(ws + WS_SSQ);
    for (int row = gw; row < MT; row += NGW) {
        const f32x4* xr = (const f32x4*)(x + (size_t)row * DM) + lane; f32x4 v[4]; float s = 0.f;
#pragma unroll
        for (int j = 0; j < 4; ++j) { v[j] = xr[64 * j]; s += (v[j].x * v[j].x + v[j].y * v[j].y) + (v[j].z * v[j].z + v[j].w * v[j].w); }
        s = wave_sum(s);
        u32x2* o = (u32x2*)(xb + (size_t)row * DM) + lane;
#pragma unroll
        for (int j = 0; j < 4; ++j) { u32x2 w; w.x = pk_bf16(v[j].x, v[j].y); w.y = pk_bf16(v[j].z, v[j].w); o[64 * j] = w; }
        if (lane < 16) ssq[(size_t)row * 16 + lane] = lane == 0 ? s : 0.f;
    }
}
__device__ __forceinline__ void final_norm(const Params& P, int gw, int NGW, int lane_in) {
    int tid_o = threadIdx.x; asm volatile("" : "+v"(tid_o)); const int lane = tid_o & 63; (void)lane_in;
    const float* ssq = (const float*)(P.ws + WS_SSQ); const float* g = P.in[16]; float* X = P.out; const bf16* xb = (const bf16*)(P.ws + WS_XB);
    f32x4 gv[4];
#pragma unroll
    for (int j = 0; j < 4; ++j) gv[j] = *((const f32x4*)g + lane + 64 * j);
    for (int row = gw; row < MT; row += NGW) {
        float s = lane < 16 ? ssq[(size_t)row * 16 + lane] : 0.f; s = wave_sum(s);
        const float r = rsqrtf(s * (1.0f / DM) + EPS);
        const u32x2* xr = (const u32x2*)(xb + (size_t)row * DM) + lane; f32x4* orow = (f32x4*)(X + (size_t)row * DM) + lane;
#pragma unroll
        for (int j = 0; j < 4; ++j) { const u32x2 w = xr[64 * j];
            const f32x4 v = (f32x4){__uint_as_float(w.x << 16), __uint_as_float(w.x & 0xffff0000u), __uint_as_float(w.y << 16), __uint_as_float(w.y & 0xffff0000u)};
            orow[64 * j] = v * r * gv[j]; }
    }
}

__device__ __forceinline__ int crow(int r, int hi) { return (r & 3) + 8 * (r >> 2) + 4 * hi; }
typedef short v4i16_t __attribute__((ext_vector_type(4)));
__device__ __forceinline__ s16x4 tr_read(const LAS unsigned char* p) { return __builtin_bit_cast(s16x4, __builtin_amdgcn_ds_read_tr16_b64_v4i16((LAS v4i16_t*)p)); }
__device__ __forceinline__ bf16x8 cat8(s16x4 lo, s16x4 hi) { return (bf16x8){lo[0], lo[1], lo[2], lo[3], hi[0], hi[1], hi[2], hi[3]}; }
__device__ __forceinline__ float max3f(float a, float b, float c) { float r; asm("v_max3_f32 %0, %1, %2, %3" : "=v"(r) : "v"(a), "v"(b), "v"(c)); return r; }
__device__ __forceinline__ float max2f(float a, float b) { float r; asm("v_max_f32_e32 %0, %1, %2" : "=v"(r) : "v"(a), "v"(b)); return r; }
typedef float f32x2_t __attribute__((ext_vector_type(2))); typedef __bf16 bf16x2_t __attribute__((ext_vector_type(2)));
__device__ __forceinline__ unsigned cvtpk_s(float lo, float hi) { f32x2_t v = {lo, hi}; bf16x2_t b = __builtin_convertvector(v, bf16x2_t); return __builtin_bit_cast(unsigned, b); }
#define MFMA32(a, b, c) __builtin_amdgcn_mfma_f32_32x32x16_bf16((a), (b), (c), 0, 0, 0)

namespace attA {
constexpr int KPIECE = 1040, VPIECE = 1088, KIMG = 16 * KPIECE, STAGE = KIMG + 16 * VPIECE, NT = SEQ / 64;
template <int IMM> __device__ __forceinline__ void glds16(unsigned voff, const void* sbase_, unsigned lds_dst) { unsigned keep;
    const unsigned long long a_ = (unsigned long long)sbase_;
    const unsigned long long sbase = ((unsigned long long)(unsigned)__builtin_amdgcn_readfirstlane((unsigned)(a_ >> 32)) << 32) | (unsigned)__builtin_amdgcn_readfirstlane((unsigned)a_);
    asm volatile("s_mov_b32 %0, m0\n\ts_mov_b32 m0, %3\n\ts_nop 0\n\tglobal_load_lds_dwordx4 %1, %2 offset:%c4\n\ts_mov_b32 m0, %0" : "=&s"(keep) : "v"(voff), "s"(sbase), "s"(lds_dst), "i"(IMM) : "memory"); }
__device__ __forceinline__ void phase(LAS unsigned char* lds, const bf16* Q, const bf16* K, const bf16* V, bf16* AO, const float* lam, const float* subln, int vcu, int G) {
    int tid_o = threadIdx.x; asm volatile("" : "+v"(tid_o)); const int tid = tid_o, lane = tid & 63, wid = __builtin_amdgcn_readfirstlane(tid >> 6), r32 = lane & 31, hi = lane >> 5, comp = wid & 1, rg = wid >> 1;
    constexpr float OUT_SCALE = 0.8f;
    const unsigned ldsb = (unsigned)(uintptr_t)lds;
    const unsigned goffb = (unsigned)(((16 * (lane >> 4)) * DM + (lane & 15) * 8) * 2);
#define ATT_DMA_P(base_, t_, stage_, p_, img_, pstride_) glds16<0>(goffb + (unsigned)((p_) * 2048), (base_) + (size_t)(t_) * (64 * DM), (unsigned)__builtin_amdgcn_readfirstlane(ldsb + (unsigned)((stage_) * STAGE + (img_) + (p_) * (pstride_))))
#define ATT_DMA_KB(kbase_, t_, stage_) do { ATT_DMA_P(kbase_, t_, stage_, 2 * wid, 0, KPIECE); ATT_DMA_P(kbase_, t_, stage_, 2 * wid + 1, 0, KPIECE); } while (0)
#define ATT_DMA_VB(vbase_, t_, stage_) do { ATT_DMA_P(vbase_, t_, stage_, 2 * wid, KIMG, VPIECE); ATT_DMA_P(vbase_, t_, stage_, 2 * wid + 1, KIMG, VPIECE); } while (0)
    if (vcu < BATCH * 8 * (SEQ / 128)) { const int bh0 = vcu >> 5; const size_t rb0 = (size_t)(bh0 >> 3) * SEQ; const bf16* k0_ = K + rb0 * DM + (bh0 & 7) * 128; const bf16* v0_ = V + rb0 * DM + (bh0 & 7) * 128;
        ATT_DMA_KB(k0_, 0, 2); ATT_DMA_VB(v0_, 0, 2); ATT_DMA_KB(k0_, 1, 3); ATT_DMA_VB(v0_, 1, 3); }
    bf16x8 qr[4];
#define ATT_LOADQ(u_) do { const int bh_ = (u_) >> 5, qb_ = (u_) & 31; int r32q = r32; asm volatile("" : "+v"(r32q)); \
        const bf16* qp_ = Q + ((size_t)(bh_ >> 3) * SEQ + qb_ * 128 + rg * 32 + r32q) * DM + (bh_ & 7) * 128 + comp * 64 + hi * 8; \
        _Pragma("unroll") for (int d0 = 0; d0 < 4; ++d0) qr[d0] = *(const bf16x8*)(qp_ + d0 * 16); } while (0)
    if (vcu < BATCH * 8 * (SEQ / 128)) ATT_LOADQ(vcu);
    for (int u = vcu; u < BATCH * 8 * (SEQ / 128); u += G) {
        const int bh = u >> 5, qb = u & 31, b = bh >> 3, h = bh & 7;
        const size_t rowbase = (size_t)b * SEQ;
        const bf16* kbase = K + rowbase * DM + h * 128; const bf16* vbase = V + rowbase * DM + h * 128;
#define ATT_DMA_K(t_, stage_) ATT_DMA_KB(kbase, t_, stage_)
#define ATT_DMA_V(t_, stage_) ATT_DMA_VB(vbase, t_, stage_)
#define ATT_WAIT_BAR() asm volatile("s_waitcnt vmcnt(0) lgkmcnt(0)\n\ts_barrier" ::: "memory")
        const unsigned kb = (unsigned)((r32 & 15) * KPIECE + (r32 >> 4) * 256 + comp * 128 + hi * 16);
        const unsigned vb0 = (unsigned)(KIMG + (4 * hi + ((lane & 15) >> 2)) * VPIECE + ((lane >> 4) & 1) * 32 + (lane & 3) * 8);
#define SBAR() __builtin_amdgcn_sched_barrier(0)
#define VRD(i) do { const LAS unsigned char* vp_ = lds + (svo + vb0) + (((i) >> 2) * 256 + ((i) & 3) * 64); vlo[(i) % 6] = tr_read(vp_); vhi[(i) % 6] = tr_read(vp_ + 8 * VPIECE); } while (0)
#define PVM(i) oT[(i) & 3] = MFMA32(cat8(vlo[(i) % 6], vhi[(i) % 6]), __builtin_bit_cast(bf16x8, pw[(i) >> 2]), oT[(i) & 3])
#define KRD(j) ka[(j) % 4] = *(const LAS bf16x8*)(lds + (sko + kb) + (((j) & 1) * 512 + ((j) >> 1) * 32))
#define QKM(C0, C1, j) do { if ((j) == 0) C0 = MFMA32(ka[0], qr[0], negm); else if ((j) == 1) C1 = MFMA32(ka[1], qr[0], negm); \
        else if ((j) & 1) C1 = MFMA32(ka[(j) % 4], qr[(j) >> 1], C1); else C0 = MFMA32(ka[(j) % 4], qr[(j) >> 1], C0); } while (0)
#define MAXSTEP(P0, P1, k) do { mxa = max3f(mxa, P0[2 * (k)], P0[2 * (k) + 1]); mxb = max3f(mxb, P1[2 * (k)], P1[2 * (k) + 1]); } while (0)
#define EXPSTEP2(P, i, W) do { P[2 * (i)] = fast_exp2(P[2 * (i)]); P[2 * (i) + 1] = fast_exp2(P[2 * (i) + 1]); rsum += P[2 * (i)]; rsum2 += P[2 * (i) + 1]; \
        pw[W][(i) & 3] = cvtpk_s(P[2 * (i)], P[2 * (i) + 1]); \
        asm volatile("" : "+v"(pw[W]), "+v"(P), "+v"(rsum), "+v"(rsum2)); } while (0)
#define STEP(first_, DMAK_, DMAV_, P0, P1, C0, C1) do { \
        float mxa = NEGBIG, mxb = NEGBIG, rsum = 0.f, rsum2 = 0.f; \
        PVM(0); MAXSTEP(P0, P1, 0); MAXSTEP(P0, P1, 1); VRD(6); SBAR(); \
        PVM(1); MAXSTEP(P0, P1, 2); MAXSTEP(P0, P1, 3); VRD(7); SBAR(); \
        PVM(2); MAXSTEP(P0, P1, 4); MAXSTEP(P0, P1, 5); VRD(8); SBAR(); \
        PVM(3); MAXSTEP(P0, P1, 6); MAXSTEP(P0, P1, 7); VRD(9); SBAR(); \
        float mx = max2f(mxa, mxb); \
        PVM(4); DMAK_; VRD(10); SBAR(); \
        PVM(5); DMAV_; VRD(11); SBAR(); \
          \
        alpha = 1.f; \
        if (first_ || __any(mx > ATT_THR)) { const float mxx = max2f(mx, __shfl_xor(mx, 32)); const float dl = first_ ? mxx : __builtin_fmaxf(mxx, 0.f); m += dl; alpha = first_ ? 1.f : fast_exp2(-dl);     \
            _Pragma("unroll") for (int r = 0; r < 16; ++r) { P0[r] -= dl; P1[r] -= dl; } \
            _Pragma("unroll") for (int r = 0; r < 16; ++r) negm[r] = -m; } \
        asm volatile("" : "+v"(alpha), "+v"(m), "+v"(negm)); \
        PVM(6);  EXPSTEP2(P0, 0, 0); VRD(12); SBAR(); \
        PVM(7);  EXPSTEP2(P0, 1, 0); VRD(13); SBAR(); \
        PVM(8);  EXPSTEP2(P0, 2, 0); VRD(14); SBAR(); \
        PVM(9);  EXPSTEP2(P0, 3, 0); VRD(15); SBAR(); \
        PVM(10); EXPSTEP2(P0, 4, 1); SBAR(); \
        PVM(11); EXPSTEP2(P0, 5, 1); SBAR(); \
        PVM(12); EXPSTEP2(P0, 6, 1);  KRD(0); SBAR(); \
        PVM(13); EXPSTEP2(P0, 7, 1); KRD(1); SBAR(); \
        PVM(14); EXPSTEP2(P1, 0, 2); KRD(2); SBAR(); \
        PVM(15); EXPSTEP2(P1, 1, 2); KRD(3); SBAR(); \
        QKM(C0, C1, 0); EXPSTEP2(P1, 2, 2); KRD(4); SBAR(); \
        QKM(C0, C1, 1); EXPSTEP2(P1, 3, 2); KRD(5); SBAR(); \
        QKM(C0, C1, 2); EXPSTEP2(P1, 4, 3); KRD(6); SBAR(); \
        QKM(C0, C1, 3); EXPSTEP2(P1, 5, 3); KRD(7); SBAR(); \
        QKM(C0, C1, 4); EXPSTEP2(P1, 6, 3); SBAR(); \
        QKM(C0, C1, 5); EXPSTEP2(P1, 7, 3); SBAR(); \
        QKM(C0, C1, 6); l = l * alpha + (rsum + rsum2); asm volatile("" : "+v"(l)); SBAR(); \
        QKM(C0, C1, 7); SBAR(); \
        if (__any(alpha != 1.0f)) { _Pragma("unroll") for (int d0 = 0; d0 < 4; ++d0) _Pragma("unroll") for (int r = 0; r < 16; ++r) oT[d0][r] *= alpha; } \
        } while (0)
        ATT_WAIT_BAR();
        f32x16 pA0 = f32x16{}, pA1 = f32x16{}, pB0, pB1;
#pragma unroll
        for (int d0 = 0; d0 < 4; ++d0) { const bf16x8 a0 = *(const LAS bf16x8*)(lds + (2 * STAGE + kb) + d0 * 32), a1 = *(const LAS bf16x8*)(lds + (2 * STAGE + kb) + 512 + d0 * 32); pA0 = MFMA32(a0, qr[d0], pA0); pA1 = MFMA32(a1, qr[d0], pA1); }
        f32x16 oT[4];
#pragma unroll
        for (int d0 = 0; d0 < 4; ++d0) oT[d0] = f32x16{};
        float m = 0.f, l = 0.f, alpha = 1.f; u32x4 pw[4] = {}; f32x16 negm = f32x16{};
        constexpr float ATT_THR = 4.0f;
        s16x4 vlo[6], vhi[6]; bf16x8 ka[4];
        { const unsigned svo = (unsigned)(2 * STAGE); VRD(0); VRD(1); VRD(2); VRD(3); VRD(4); VRD(5); }
#define ATT_ITER(t_, P0, P1, C0, C1) do { \
        ATT_WAIT_BAR(); \
        { const unsigned svo = (unsigned)(((t_) == 0 ? 2 : (((t_) + 1) & 3)) * STAGE), sko = (unsigned)((((t_) + 3) & 3) * STAGE); \
          STEP(((t_) == 0), if ((t_) + 2 < NT) ATT_DMA_K((t_) + 2, (t_) & 3), if ((t_) + 2 < NT) ATT_DMA_V((t_) + 2, (t_) & 3), P0, P1, C0, C1); }     \
        { const unsigned svo = (unsigned)((((t_) + 2) & 3) * STAGE); VRD(0); VRD(1); VRD(2); VRD(3); VRD(4); VRD(5); }     \
        } while (0)
#pragma unroll 1
        for (int t = 0; t < NT; t += 2) {
            ATT_ITER(t, pA0, pA1, pB0, pB1);
            ATT_ITER(t + 1, pB0, pB1, pA0, pA1);
        }
        { const unsigned svo = (unsigned)(((NT + 1) & 3) * STAGE);
#pragma unroll
          for (int s = 0; s < 4; ++s)
#pragma unroll
              for (int d0 = 0; d0 < 4; ++d0) { const LAS unsigned char* vp = lds + (svo + vb0) + (s * 256 + d0 * 64);
                  oT[d0] = MFMA32(cat8(tr_read(vp), tr_read(vp + 8 * VPIECE)), __builtin_bit_cast(bf16x8, pw[s]), oT[d0]); } }
        __syncthreads();
#undef ATT_DMA
#undef ATT_DMA_K
#undef ATT_DMA_V
#undef ATT_WAIT_BAR
#undef SBAR
#undef VRD
#undef PVM
#undef KRD
#undef QKM
#undef MAXSTEP
#undef EXPSTEP
#undef STEP
#undef ATT_ITER
        l += __shfl_xor(l, 32);
        const float inv = 1.0f / l;
        LAS float* mb = (LAS float*)lds;
        if (comp == 1) {
            float lam_full;
            { const float a = lam[lane] * lam[64 + lane], b = lam[128 + lane] * lam[192 + lane]; lam_full = __expf(wave_sum(a)) - __expf(wave_sum(b)) + 0.2f; }
            const float sc = inv * lam_full;
#pragma unroll
            for (int d0 = 0; d0 < 4; ++d0)
#pragma unroll
                for (int r = 0; r < 16; ++r) mb[((d0 * 16 + r) * 4 + rg) * 64 + lane] = oT[d0][r] * sc;
        }
        __syncthreads();
        if (comp == 1 && u + G < BATCH * 8 * (SEQ / 128)) { const int bhn = (u + G) >> 5; const size_t rbn = (size_t)(bhn >> 3) * SEQ; const bf16* kn_ = K + rbn * DM + (bhn & 7) * 128; const bf16* vn_ = V + rbn * DM + (bhn & 7) * 128;
#pragma unroll
            for (int j = 0; j < 4; ++j) { const int p_ = 4 * rg + j;
                ATT_DMA_P(kn_, 0, 2, p_, 0, KPIECE); ATT_DMA_P(vn_, 0, 2, p_, KIMG, VPIECE); ATT_DMA_P(kn_, 1, 3, p_, 0, KPIECE); ATT_DMA_P(vn_, 1, 3, p_, KIMG, VPIECE); } }
        if (comp == 0) {
            float ss = 0.f;
#pragma unroll
            for (int d0 = 0; d0 < 4; ++d0)
#pragma unroll
                for (int r = 0; r < 16; ++r) { const float o = oT[d0][r] * inv - mb[((d0 * 16 + r) * 4 + rg) * 64 + lane]; oT[d0][r] = o; ss += o * o; }
            ss += __shfl_xor(ss, 32);
            const float rstd = rsqrtf(ss * (1.0f / 128.0f) + EPS) * OUT_SCALE;
            int r32o = r32; asm volatile("" : "+v"(r32o));
            bf16* op = AO + (rowbase + qb * 128 + rg * 32 + r32o) * DM + h * 128;
#pragma unroll
            for (int d0 = 0; d0 < 4; ++d0)
#pragma unroll
                for (int gp = 0; gp < 2; ++gp) { u32x2 w[2];
#pragma unroll
                    for (int k = 0; k < 2; ++k) { const int g4 = 2 * gp + k; const f32x4 gl = *(const f32x4*)(subln + 32 * d0 + 8 * g4 + 4 * hi);
                        w[k].x = pk_bf16(oT[d0][4 * g4 + 0] * rstd * gl.x, oT[d0][4 * g4 + 1] * rstd * gl.y); w[k].y = pk_bf16(oT[d0][4 * g4 + 2] * rstd * gl.z, oT[d0][4 * g4 + 3] * rstd * gl.w); }
                    const auto r0 = __builtin_amdgcn_permlane32_swap(w[0].x, w[1].x, false, false), r1 = __builtin_amdgcn_permlane32_swap(w[0].y, w[1].y, false, false);
                    u32x4 o; o.x = r0[0]; o.y = r1[0]; o.z = r0[1]; o.w = r1[1];
                    *(u32x4*)(op + 32 * d0 + 8 * (2 * gp + hi)) = o; }
        }
        if (u + G < BATCH * 8 * (SEQ / 128)) ATT_LOADQ(u + G);
        __syncthreads();
    }
#undef ATT_LOADQ
}
}


namespace attB {
constexpr int OSTR = 68  , VSTW = 128  , VW_BYTES = 32 * VSTW, ACC_BYTES = 256 * OSTR * 4;
__device__ __forceinline__ void phase(LAS unsigned char* lds, const bf16* R, bf16* AO  , int vcu, int G) {
    int tid_o = threadIdx.x; asm volatile("" : "+v"(tid_o)); const int tid = tid_o, lane = tid & 63, wid = __builtin_amdgcn_readfirstlane(tid >> 6), r32 = lane & 31, hi = lane >> 5;
    LAS float* acc = (LAS float*)lds;
    LAS unsigned char* vst = lds + ACC_BYTES + wid * (2 * VW_BYTES);
    const int vfo = (4 * hi + ((lane & 15) >> 2)) * VSTW + ((lane >> 4) & 1) * 32 + (lane & 3) * 8;
    constexpr size_t SEGS = (size_t)MH * DM;
#define ATTB_PARAMS(item_) \
        const int g = (item_) < 2 ? (item_) : 2, dsh = 2 * g, L = SEQ >> dsh, nq = g == 2 ? 16 : 32; \
        const int p = g == 0 ? 0 : (g == 1 ? (wid & 3) : wid + 8 * ((item_) - 2)); \
        const int mq0 = g == 0 ? t0 + 32 * wid : (g == 1 ? (t0 >> 2) + 32 * (wid >> 2) : (t0 >> 4)); \
        const int mk0 = mq0 - 64; (void)nq; (void)L; (void)p; (void)mk0;
#define ATTB_ORDER(jj_) ((jj_) == 0 ? 2 : ((jj_) < 3 ? (jj_) - 1 : (jj_)))
#define ATTB_LOADS(S_, step_) do { ATTB_PARAMS((step_) / 5) const char* Kh_ = (const char*)(R + (size_t)(2 * g + 1) * SEGS + rowbase * DM + h * 64); \
        int lane_o = lane; asm volatile("" : "+v"(lane_o)); const int r32 = lane_o & 31, hi = lane_o >> 5, lane = lane_o;     \
        const int mkb_ = mk0 + 32 * ATTB_ORDER((step_) % 5); int mk_ = mkb_ + r32; mk_ = mk_ < 0 ? 0 : (mk_ >= L ? L - 1 : mk_); \
        const unsigned ko_ = (unsigned)(((mk_ << dsh) + p) * (DM * 2) + hi * 16);        \
        _Pragma("unroll") for (int d0 = 0; d0 < 4; ++d0) ka[S_][d0] = *(const bf16x8*)(Kh_ + (ko_ + (unsigned)(d0 * 32))); \
        _Pragma("unroll") for (int i = 0; i < 4; ++i) { const int idx = lane + 64 * i, row = idx >> 3, ch = idx & 7; int mv = mkb_ + row; mv = mv < 0 ? 0 : (mv >= L ? L - 1 : mv); \
            vv[S_][i] = *(const u32x4*)((const char*)Vh + (unsigned)(((mv << dsh) + p) * (DM * 2) + ch * 16)); } } while (0)
#define ATTB_LOADQ(QS_, item_) do { ATTB_PARAMS(item_) const int tokq_ = ((mq0 + (r32 & (nq - 1))) << dsh) + p; const char* Qh_ = (const char*)(R + (size_t)(2 * g) * SEGS + rowbase * DM + h * 64); \
        const unsigned qo_ = (unsigned)(tokq_ * (DM * 2) + hi * 16); \
        _Pragma("unroll") for (int d0 = 0; d0 < 4; ++d0) qr[QS_][d0] = *(const bf16x8*)(Qh_ + (qo_ + (unsigned)(d0 * 32))); } while (0)
    bf16x8 ka[2][4], qr[2][4]; u32x4 vv[2][4];
    if (vcu < 4 * 16 * 16) { const int blk = vcu & 15, h = (vcu >> 4) & 15, b = vcu >> 8, t0 = blk * 256; const size_t rowbase = (size_t)b * SEQ; const bf16* Vh = R + 6 * SEGS + rowbase * DM + h * 64;
        ATTB_LOADQ(0, 0); ATTB_LOADS(0, 0); }
    for (int u = vcu; u < 4 * 16 * 16; u += G) {
        const int blk = u & 15, h = (u >> 4) & 15, b = u >> 8, t0 = blk * 256;
        const size_t rowbase = (size_t)b * SEQ;
        const bf16* Vh = R + 6 * SEGS + rowbase * DM + h * 64;
        f32x16 oT[2]; float m = 0.f, l = 0.f;
#pragma unroll
        for (int i = 0; i < 4; ++i) { const int idx = lane + 64 * i, row = idx >> 3, ch = idx & 7; *(LAS u32x4*)(vst + row * VSTW + ch * 16) = vv[0][i]; }
#pragma unroll
        for (int step = 0; step < 20; ++step) {
            const int item = step / 5, jj = step % 5, S = step % 2, QS = item & 1;
            ATTB_PARAMS(item)
            const int qi = r32 & (nq - 1), mq = mq0 + qi, tokq = (mq << dsh) + p;
            if (step + 1 < 20) ATTB_LOADS((step + 1) % 2, step + 1);
            if (jj == 0) { if (item + 1 < 4) ATTB_LOADQ((item + 1) & 1, item + 1); oT[0] = f32x16{}; oT[1] = f32x16{}; m = 0.f; l = 0.f; }
            const int mkb = mk0 + 32 * ATTB_ORDER(jj);
            f32x16 p0 = f32x16{};
#pragma unroll
            for (int d0 = 0; d0 < 4; ++d0) p0 = MFMA32(ka[S][d0], qr[QS][d0], p0);
            if (ATTB_ORDER(jj) == 0 || ATTB_ORDER(jj) == 4 || mkb < 0 || mkb + 32 > L) {
                int mqo = mq; asm volatile("" : "+v"(mqo));
                const int base_ = mkb + 4 * hi, lo = max(mqo - 64, 0) - base_, hi_ = min(mqo + 64, L - 1) - base_;
#pragma unroll
                for (int r = 0; r < 16; ++r) { const int c = (r & 3) + 8 * (r >> 2); p0[r] = (((c - lo) | (hi_ - c)) < 0) ? NEGBIG : p0[r]; }
            }
            float mx = max3f(p0[0], p0[1], p0[2]);
#pragma unroll
            for (int r = 3; r < 15; r += 2) mx = max3f(mx, p0[r], p0[r + 1]);
            mx = max2f(mx, p0[15]);
            float alpha = 1.f;
            if (jj == 0 || __any(mx - m > 4.0f)) {
                const auto rr = __builtin_amdgcn_permlane32_swap(__float_as_uint(mx), __float_as_uint(mx), false, false); const float mxx = max2f(__uint_as_float(rr[0]), __uint_as_float(rr[1]));
                const float mnew = jj == 0 ? mxx : max2f(m, mxx); alpha = jj == 0 ? 1.f : fast_exp2(m - mnew); m = mnew;
                if (jj != 0) {
#pragma unroll
                    for (int d0 = 0; d0 < 2; ++d0)
#pragma unroll
                        for (int r = 0; r < 16; ++r) oT[d0][r] *= alpha;
                }
            }
            float rsum = 0.f;
#pragma unroll
            for (int r = 0; r < 16; ++r) { p0[r] = fast_exp2(p0[r] - m); rsum += p0[r]; }
            l = l * alpha + rsum;
            bf16x8 pb[2];
#pragma unroll
            for (int s = 0; s < 2; ++s) { u32x4 w0; w0.x = pk_bf16(p0[8 * s + 0], p0[8 * s + 1]); w0.y = pk_bf16(p0[8 * s + 2], p0[8 * s + 3]); w0.z = pk_bf16(p0[8 * s + 4], p0[8 * s + 5]); w0.w = pk_bf16(p0[8 * s + 6], p0[8 * s + 7]);
                pb[s] = __builtin_bit_cast(bf16x8, w0); }
            asm volatile("s_waitcnt lgkmcnt(0)" ::: "memory");
#pragma unroll
            for (int s = 0; s < 2; ++s)
#pragma unroll
                for (int d0 = 0; d0 < 2; ++d0) { const LAS unsigned char* vp = vst + S * VW_BYTES + vfo + (16 * s) * VSTW + d0 * 64;
                    const bf16x8 vf = cat8(tr_read(vp), tr_read(vp + 8 * VSTW));
                    oT[d0] = MFMA32(vf, pb[s], oT[d0]); }
            if (step + 1 < 20) {
#pragma unroll
                for (int i = 0; i < 4; ++i) { const int idx = lane + 64 * i, row = idx >> 3, ch = idx & 7; *(LAS u32x4*)(vst + ((step + 1) % 2) * VW_BYTES + row * VSTW + ch * 16) = vv[(step + 1) % 2][i]; }
            }
            if (jj == 4) {
                l += __shfl_xor(l, 32);
                const int tl = tokq - t0;
                LAS float* arow = acc + tl * OSTR;
                if (r32 < nq) {
                    if (g == 0) {
#pragma unroll
                        for (int d0 = 0; d0 < 2; ++d0)
#pragma unroll
                            for (int g4 = 0; g4 < 4; ++g4) *(LAS f32x4*)(arow + 32 * d0 + 8 * g4 + 4 * hi) = (f32x4){oT[d0][4 * g4], oT[d0][4 * g4 + 1], oT[d0][4 * g4 + 2], oT[d0][4 * g4 + 3]};
                        if (hi == 0) { arow[64] = m; arow[65] = l; }
                    } else {
                        const float ma = arow[64], la = arow[65];
                        const float mn = fmaxf(ma, m), fa = fast_exp2(ma - mn), fw = fast_exp2(m - mn);
#pragma unroll
                        for (int d0 = 0; d0 < 2; ++d0)
#pragma unroll
                            for (int g4 = 0; g4 < 4; ++g4) { LAS f32x4* ap = (LAS f32x4*)(arow + 32 * d0 + 8 * g4 + 4 * hi); const f32x4 a = *ap;
                                *ap = a * fa + (f32x4){oT[d0][4 * g4], oT[d0][4 * g4 + 1], oT[d0][4 * g4 + 2], oT[d0][4 * g4 + 3]} * fw; }
                        asm volatile("s_waitcnt lgkmcnt(0)" ::: "memory");
                        if (hi == 0) { arow[64] = mn; arow[65] = la * fa + l * fw; }
                    }
                }
                if (item != 2) __syncthreads();
            }
        }
        if (u + G < 4 * 16 * 16) { const int u2 = u + G; const int blk = u2 & 15, h = (u2 >> 4) & 15, b = u2 >> 8, t0 = blk * 256; const size_t rowbase = (size_t)b * SEQ; const bf16* Vh = R + 6 * SEGS + rowbase * DM + h * 64;
            ATTB_LOADQ(0, 0); ATTB_LOADS(0, 0); }
        { const int tl = tid >> 1, hf = tid & 1; const LAS float* arow = acc + tl * OSTR; const float inv = 1.0f / arow[65];
          bf16* op = AO + (rowbase + t0 + tl) * DM + h * 64 + 32 * hf;
#pragma unroll
          for (int c = 0; c < 4; ++c) { const f32x4 a = *(const LAS f32x4*)(arow + 32 * hf + 8 * c) * inv, bq = *(const LAS f32x4*)(arow + 32 * hf + 8 * c + 4) * inv;
              u32x4 w; w.x = pk_bf16(a.x, a.y); w.y = pk_bf16(a.z, a.w); w.z = pk_bf16(bq.x, bq.y); w.w = pk_bf16(bq.z, bq.w); *(u32x4*)(op + 8 * c) = w; } }
        __syncthreads();
    }
#undef ATTB_PARAMS
#undef ATTB_ORDER
#undef ATTB_LOADS
#undef ATTB_LOADQ
}
}


#define GEMM_PHASE(EPI_T, A_, BT_, M_, N_, K_, ...) do { pg8::Gemm g_{(const pg8::bf16_t*)(A_), (const pg8::bf16_t*)(BT_), (M_), (N_), (K_)}; int bx_ = (int)blockIdx.x; asm volatile("" : "+s"(bx_)); pg8::StaticOrder S_; S_.init((M_), (N_), G, bx_);     \
    EPI_T E_{__VA_ARGS__}; pg8::gemm_phase<EPI_T, pg8::StaticOrder, true, true>(lds, g_, S_, E_); } while (0)

__global__ void __launch_bounds__(512, 2) fwd_megakernel(Params P) {
    extern __shared__ __attribute__((aligned(16))) unsigned char lds_raw[];
    LAS unsigned char* lds = (LAS unsigned char*)lds_raw;
    cg::grid_group grid = cg::this_grid();
    const int tid = threadIdx.x, lane = tid & 63, wave = __builtin_amdgcn_readfirstlane(tid >> 6);
    const int G = gridDim.x, bx = blockIdx.x, vcu = (G % 8 == 0) ? (bx % 8) * (G / 8) + bx / 8 : bx;
    const int gw = vcu * 8 + wave, NGW = G * 8;
    unsigned char* ws = P.ws;
    float* ssq = (float*)(ws + WS_SSQ); const float* cosT = (const float*)(ws + WS_COS); const float* sinT = (const float*)(ws + WS_SIN);
    bf16* XB = (bf16*)(ws + WS_XB); bf16* AO = (bf16*)(ws + WS_AO); bf16* R = (bf16*)(ws + WS_R);

    if (tid < 64) ((LAS unsigned*)(lds + LDS_CTL))[tid] = 0u;
    __syncthreads();
    XcdBarrier bar = xcd_barrier_post((unsigned*)(ws + WS_BAR), (volatile LAS unsigned*)(lds + LDS_CTL) + 8);
    prologue(P, lds, gw, NGW, wave, lane);
    grid.sync();
#pragma unroll 1
    for (int layer = 0; layer < 2; ++layer) {
        { const bf16* wgu = (const bf16*)(ws + WS_W + (size_t)(2 * layer) * FFN_W_BYTES); const bf16* wd = wgu + (size_t)NGU * DM;
          GEMM_PHASE(EpiSwiGLU, XB, wgu, MT, NGU, DM, R, ssq);
          xcd_barrier(bar);
          GEMM_PHASE(EpiResid, R, wd, MT, DM, DFF, XB, ssq, 0.5f);
          xcd_barrier(bar); }
        if (layer == 0) {
            GEMM_PHASE(EpiProj, XB, ws + WS_WQKV, MT, NQKV, DM, R, (size_t)MT * DM, ssq, cosT, sinT, 0, 2);
            xcd_barrier(bar);
            attA::phase(lds, R, R + (size_t)MT * DM, R + (size_t)2 * MT * DM, AO, P.in[8], P.in[9], vcu, G);
            xcd_barrier(bar);
            GEMM_PHASE(EpiResid, AO, ws + WS_WOA, MT, DM, DM, XB, ssq, 1.0f);
            xcd_barrier(bar);
        } else {
#pragma unroll 1
            for (int half = 0; half < 2; ++half) {
                GEMM_PHASE(EpiProj, XB + (size_t)half * MH * DM, ws + WS_WIN, MH, NBIN, DM, R, (size_t)MH * DM, ssq, cosT, sinT, half * MH, 6);
                xcd_barrier(bar);
                attB::phase(lds, R, AO + (size_t)half * MH * DM, vcu, G);
                xcd_barrier(bar);
            }
            GEMM_PHASE(EpiResid, AO, ws + WS_WOB, MT, DM, DM, XB, ssq, 1.0f);
            xcd_barrier(bar);
        }
        { const bf16* wgu = (const bf16*)(ws + WS_W + (size_t)(2 * layer + 1) * FFN_W_BYTES); const bf16* wd = wgu + (size_t)NGU * DM;
          GEMM_PHASE(EpiSwiGLU, XB, wgu, MT, NGU, DM, R, ssq);
          xcd_barrier(bar);
          GEMM_PHASE(EpiResid, R, wd, MT, DM, DFF, XB, ssq, 0.5f);
          xcd_barrier(bar); }
    }
    final_norm(P, gw, NGW, lane);
}

extern "C" void kernel_launch(void* const* d_in, const int* in_sizes, int n_in, void* d_out, int out_size, void* d_ws, size_t ws_size, hipStream_t stream) {
    static int grid = 0;
    if (grid == 0) {
        if (n_in != 17 || out_size != MT * DM || ws_size < WS_END) { fprintf(stderr, "kernel_launch: unexpected shapes (n_in %d out %d ws %zu)\n", n_in, out_size, ws_size); grid = -1; return; }
        int dev = 0, cus = 0, per_cu = 0;
        hipGetDevice(&dev); hipDeviceGetAttribute(&cus, hipDeviceAttributeMultiprocessorCount, dev);
        if (hipFuncSetAttribute((const void*)fwd_megakernel, hipFuncAttributeMaxDynamicSharedMemorySize, LDS_BYTES) != hipSuccess) { fprintf(stderr, "kernel_launch: hipFuncSetAttribute failed\n"); grid = -1; return; }
        if (hipOccupancyMaxActiveBlocksPerMultiprocessor(&per_cu, (const void*)fwd_megakernel, 512, LDS_BYTES) != hipSuccess || per_cu < 1) { fprintf(stderr, "kernel_launch: occupancy query failed (%d)\n", per_cu); (void)hipGetLastError(); per_cu = 1; }
        grid = cus * per_cu;
    }
    if (grid < 0) return;
    if (hipMemsetAsync((char*)d_ws + WS_BAR, 0, 16384, stream) != hipSuccess) { fprintf(stderr, "kernel_launch: memset failed\n"); return; }
    Params p{};
    for (int i = 0; i < 17; ++i) p.in[i] = (const float*)d_in[i];
    p.out = (float*)d_out; p.ws = (unsigned char*)d_ws;
    for (int i = 0; i < 32; ++i) p.invf[i] = (double)(float)pow(10000.0, -(double)(2 * i) / 64.0);
    void* args[] = {&p};
    hipError_t e = hipLaunchCooperativeKernel((const void*)fwd_megakernel, dim3(grid), dim3(512), args, LDS_BYTES, stream);
    if (e != hipSuccess) fprintf(stderr, "kernel_launch: cooperative launch failed: %s (grid %d)\n", hipGetErrorString(e), grid);
}
```
